# Optimizing an MI355X kernel written in HIP

```python
import math
import jax, jax.numpy as jnp
from jax import lax
import numpy as np

D_MODEL = 1024
BATCH = 16
SEQ = 2048
DEPTH = 4

CHUNK = 64
D_MIX = D_MODEL
LRU_HEADS = 8
LRU_WIDTH = D_MIX // 2
LRU_HEAD_DIM = LRU_WIDTH // LRU_HEADS
SC_GROUPS = 8
SC_WIDTH = D_MIX - LRU_WIDTH
SC_GROUP_DIM = SC_WIDTH // SC_GROUPS
LRU_CONV = 4
SC_CONV = 3
MLP_CONV = 3
D_FF = 3 * D_MODEL
LRU_C = 8.0
IN_COLS = 2 * LRU_WIDTH + 3 * SC_WIDTH
EPS = 1e-6

kernel_name = "hybrid_rglru_shortconv_convffn_trunk"


def rms_norm(x, g):
    xf = x.astype(jnp.float32)
    y = xf * lax.rsqrt(jnp.mean(xf * xf, axis=-1, keepdims=True) + EPS)
    return (y * g.astype(jnp.float32)).astype(x.dtype)


def causal_dwconv(x, w, b=None):
    k_width = w.shape[0]
    s = x.shape[1]
    xp = jnp.pad(x, ((0, 0), (k_width - 1, 0), (0, 0)))
    y = xp[:, 0:s] * w[0]
    for k in range(1, k_width):
        y = y + xp[:, k:k + s] * w[k]
    if b is not None:
        y = y + b
    return y


def block_diag_linear(x, w, b):
    bsz, s, _ = x.shape
    h, dh, _ = w.shape
    xh = x.reshape(bsz, s, h, dh)
    y = jnp.einsum('bshd,hde->bshe', xh, w) + b
    return y.reshape(bsz, s, h * dh)


def linear_scan(a, b):
    def combine(left, right):
        a_l, b_l = left
        a_r, b_r = right
        return a_l * a_r, a_r * b_l + b_r
    _, h = lax.associative_scan(combine, (a, b), axis=1)
    return h


def rg_lru(x, w_a, b_a, w_x, b_x, lam):
    xf = x.astype(jnp.float32)
    r = jax.nn.sigmoid(block_diag_linear(xf, w_a.astype(jnp.float32), b_a.astype(jnp.float32)))
    i = jax.nn.sigmoid(block_diag_linear(xf, w_x.astype(jnp.float32), b_x.astype(jnp.float32)))
    log_a = -LRU_C * r * jax.nn.softplus(-lam.astype(jnp.float32))
    a = jnp.exp(log_a)
    mult = jnp.sqrt(jnp.clip(-jnp.expm1(2.0 * log_a), 0.0, None))
    h = linear_scan(a, mult * (i * xf))
    return h.astype(x.dtype)


def setup_inputs(seed: int = 0) -> dict:
    key = jax.random.key(seed)
    ks = jax.random.split(key, 24)
    f32 = jnp.float32

    def nrm(k, shape, fan_in):
        return jax.random.normal(k, shape, f32) * (fan_in ** -0.5)

    def gain(k, shape):
        return 1.0 + 0.05 * jax.random.normal(k, shape, f32)

    def bias(k, shape):
        return 0.01 * jax.random.normal(k, shape, f32)

    u = jax.random.uniform(ks[7], (DEPTH, LRU_WIDTH), f32, 0.9, 0.999)
    s = u ** (1.0 / LRU_C)
    lam = jnp.log(s) - jnp.log1p(-s)

    return {
        "x": jax.random.normal(ks[0], (BATCH, SEQ, D_MODEL), f32),
        "norm1_g": gain(ks[1], (DEPTH, D_MODEL)),
        "w_in": nrm(ks[2], (DEPTH, D_MODEL, IN_COLS), D_MODEL),
        "lru_conv_w": nrm(ks[3], (DEPTH, LRU_CONV, LRU_WIDTH), LRU_CONV),
        "lru_conv_b": bias(ks[4], (DEPTH, LRU_WIDTH)),
        "lru_w_a": nrm(ks[5], (DEPTH, LRU_HEADS, LRU_HEAD_DIM, LRU_HEAD_DIM), LRU_HEAD_DIM),
        "lru_b_a": bias(ks[6], (DEPTH, LRU_HEADS, LRU_HEAD_DIM)),
        "lru_w_x": nrm(ks[8], (DEPTH, LRU_HEADS, LRU_HEAD_DIM, LRU_HEAD_DIM), LRU_HEAD_DIM),
        "lru_b_x": bias(ks[9], (DEPTH, LRU_HEADS, LRU_HEAD_DIM)),
        "lru_lambda": lam,
        "sc_conv_w": nrm(ks[10], (DEPTH, SC_CONV, SC_WIDTH), SC_CONV),
        "lru_out_g": gain(ks[11], (DEPTH, LRU_WIDTH)),
        "sc_out_g": gain(ks[12], (DEPTH, SC_WIDTH)),
        "w_out": nrm(ks[13], (DEPTH, D_MIX, D_MODEL), D_MIX),
        "norm2_g": gain(ks[14], (DEPTH, D_MODEL)),
        "mlp_w_up": nrm(ks[15], (DEPTH, D_MODEL, D_FF), D_MODEL),
        "mlp_w_gate": nrm(ks[16], (DEPTH, D_MODEL, D_FF), D_MODEL),
        "mlp_conv_w": nrm(ks[17], (DEPTH, MLP_CONV, D_FF), MLP_CONV),
        "mlp_conv_b": bias(ks[18], (DEPTH, D_FF)),
        "mlp_w_down": nrm(ks[19], (DEPTH, D_FF, D_MODEL), D_FF),
        "final_g": gain(ks[20], (D_MODEL,)),
    }


def reference(x, norm1_g, w_in, lru_conv_w, lru_conv_b, lru_w_a, lru_b_a, lru_w_x, lru_b_x,
              lru_lambda, sc_conv_w, lru_out_g, sc_out_g, w_out, norm2_g, mlp_w_up, mlp_w_gate,
              mlp_conv_w, mlp_conv_b, mlp_w_down, final_g):
    h = x
    for l in range(DEPTH):
        u = rms_norm(h, norm1_g[l])
        proj = jnp.einsum('bsd,dc->bsc', u, w_in[l])
        o = 0
        lru_x = proj[..., o:o + LRU_WIDTH]; o += LRU_WIDTH
        lru_gate = proj[..., o:o + LRU_WIDTH]; o += LRU_WIDTH
        sc_b = proj[..., o:o + SC_WIDTH]; o += SC_WIDTH
        sc_c = proj[..., o:o + SC_WIDTH]; o += SC_WIDTH
        sc_v = proj[..., o:o + SC_WIDTH]

        xa = causal_dwconv(lru_x, lru_conv_w[l], lru_conv_b[l])
        ya = rg_lru(xa, lru_w_a[l], lru_b_a[l], lru_w_x[l], lru_b_x[l], lru_lambda[l])
        ya = ya * jax.nn.gelu(lru_gate, approximate=True)

        yb = sc_b * causal_dwconv(sc_c * sc_v, sc_conv_w[l])

        y = jnp.concatenate([rms_norm(ya, lru_out_g[l]), rms_norm(yb, sc_out_g[l])], axis=-1)
        h = h + jnp.einsum('bsc,cd->bsd', y, w_out[l])

        v = rms_norm(h, norm2_g[l])
        up = jnp.einsum('bsd,df->bsf', v, mlp_w_up[l])
        gate = jnp.einsum('bsd,df->bsf', v, mlp_w_gate[l])
        act = jax.nn.gelu(causal_dwconv(up, mlp_conv_w[l], mlp_conv_b[l]), approximate=True) * gate
        h = h + jnp.einsum('bsf,fd->bsd', act, mlp_w_down[l])
    return rms_norm(h, final_g)
```

```cpp
#include <hip/hip_runtime.h>
#include <cstdio>
#include <cstdint>
namespace pg8 {
#define PG8_LAS __attribute__((address_space(3)))
typedef unsigned short bf16_t;
typedef short bf16x8 __attribute__((ext_vector_type(8)));
typedef float f32x4 __attribute__((ext_vector_type(4)));
typedef unsigned u32x4 __attribute__((ext_vector_type(4)));
constexpr int BM = 256, BK = 64, HALF = 128, HTB = HALF * BK * 2  , STAGE_BYTES = 8 * HTB, NXCD = 8, WGM = 8;

__host__ __device__ __forceinline__ int lds_byte(int r, int c) { const int st = (r >> 4) * 2 + (c >> 5), rr = r & 15, cc = c & 31, ob = rr * 64 + cc * 2; return st * 1024 + (ob ^ (((ob >> 9) & 1) << 5)); }
__host__ __device__ __forceinline__ void stage_rc(int b, int& R, int& C) { const int st = b / 1024, sb = b % 1024, swz = sb ^ (((sb >> 9) & 1) << 5); R = (st >> 1) * 16 + swz / 64; C = (st & 1) * 32 + (swz % 64) / 2; }
__host__ __device__ __forceinline__ int perm32(int rho) { const int n = rho >> 4, i = rho & 15; return 8 * (i >> 2) + 4 * n + (i & 3); }

struct Unit { int pm, pn; };
struct Gemm { const bf16_t* A; const bf16_t* Bt; int M, N, K; };

struct StaticOrder {
    int nM, nN, nwg, G, c;
    __host__ __device__ void init(int M, int N, int G_, int c_) { nM = M / BM; nN = N / BM; nwg = nM * nN; G = G_; c = c_; }
    __host__ __device__ bool next(int i, Unit& u) const {
        const long L = (long)i * G + c; if (L >= nwg) return false;
        int wgid = (int)L; { const int q = nwg / NXCD, r = nwg % NXCD, xcd = wgid % NXCD, off = wgid / NXCD; wgid = (xcd < r ? xcd * (q + 1) : r * (q + 1) + (xcd - r) * q) + off; }
        const int nig = WGM * nN, gid = wgid / nig, fm = gid * WGM, gsz = (nM - fm) < WGM ? (nM - fm) : WGM;
        u.pm = fm + ((wgid % nig) % gsz); u.pn = (wgid % nig) / gsz; return true;
    }
    __device__ __forceinline__ void a_ready(const Unit&) const {}
    __device__ __forceinline__ void done(const Unit&) const {}
};

__device__ __forceinline__ unsigned cvt_pk_bf16(float lo, float hi) { unsigned r; asm volatile("v_cvt_pk_bf16_f32 %0, %1, %2" : "=v"(r) : "v"(lo), "v"(hi)); return r; }
typedef float f32x2 __attribute__((ext_vector_type(2)));
__device__ __forceinline__ f32x2 gelu_pk(f32x2 v) {
    const f32x2 av = __builtin_elementwise_abs(v), d = av * 0.2316418882f + 1.0f;
    f32x2 t; t.x = __builtin_amdgcn_rcpf(d.x); t.y = __builtin_amdgcn_rcpf(d.y);
    f32x2 q = t * 0.5307027145f + (-0.7265760135f); q = q * t + 0.7107068705f; q = q * t + (-0.142248368f); q = q * t + 0.127414796f; q = q * t;
    const f32x2 s = (v * v) * (-0.72134752044f);
    f32x2 e; e.x = __builtin_amdgcn_exp2f(s.x); e.y = __builtin_amdgcn_exp2f(s.y);
    const f32x2 m = v * (q * e), r = v - m;
    f32x2 o; o.x = v.x < 0.f ? m.x : r.x; o.y = v.y < 0.f ? m.y : r.y; return o;
}


constexpr float RMS_EPS = 1e-6f;
__device__ __forceinline__ float dpp_ror1(float v) { return __builtin_bit_cast(float, __builtin_amdgcn_update_dpp(0, __builtin_bit_cast(int, v), 0x121, 0xf, 0xf, false)); }
__device__ __forceinline__ float dpp_ror2(float v) { return __builtin_bit_cast(float, __builtin_amdgcn_update_dpp(0, __builtin_bit_cast(int, v), 0x122, 0xf, 0xf, false)); }
__device__ __forceinline__ float gelu_tanh(float x) {
    const float z = x * (1.0f + 0.044715f * x * x) * (-2.3022081985f);
    return x * __builtin_amdgcn_rcpf(1.0f + __builtin_amdgcn_exp2f(z));
}
__device__ __forceinline__ void load_rs(const float* ssq, int r0, int fq, float (&rs)[2][4]) {
#pragma unroll
    for (int ai = 0; ai < 2; ++ai)
#pragma unroll
        for (int m = 0; m < 4; ++m) {
            const f32x4 p = *(const f32x4*)(ssq + (size_t)(r0 + ai * HALF + m * 16) * 16 + 4 * fq);
            float s = (p[0] + p[1]) + (p[2] + p[3]);
            s += __shfl_xor(s, 16); s += __shfl_xor(s, 32);
            rs[ai][m] = __builtin_amdgcn_rsqf(s * (1.0f / 1024.0f) + RMS_EPS);
        }
}
struct EpiProj {
    static constexpr bool PERM = true, AFTER_DRAIN = false;
    bf16_t* O; int ldc; const float* ssq;
    __device__ __forceinline__ void operator()(const f32x4 (&acc)[2][2][4][2], const Unit& u, int wr, int wc, int fr, int fq) const {
        const int row0 = u.pm * BM + wr * 64 + fr, col0 = u.pn * BM + wc * 32 + 8 * fq;
        float rs[2][4]; load_rs(ssq, row0, fq, rs);
#pragma unroll
        for (int ai = 0; ai < 2; ++ai)
#pragma unroll
            for (int m = 0; m < 4; ++m) { bf16_t* rowp = O + (size_t)(row0 + ai * HALF + m * 16) * ldc + col0; const float s = rs[ai][m];
#pragma unroll
                for (int bj = 0; bj < 2; ++bj) { const f32x4 v0 = acc[ai][bj][m][0] * s, v1 = acc[ai][bj][m][1] * s;
                    u32x4 w; w.x = cvt_pk_bf16(v0[0], v0[1]); w.y = cvt_pk_bf16(v0[2], v0[3]); w.z = cvt_pk_bf16(v1[0], v1[1]); w.w = cvt_pk_bf16(v1[2], v1[3]);
                    *(u32x4*)(rowp + bj * HALF) = w; } }
    }
};
struct EpiRes {
    static constexpr bool PERM = false, AFTER_DRAIN = false;
    const float* base; float* out; bf16_t* hb; float* ssq_out;
    __device__ __forceinline__ void operator()(const f32x4 (&acc)[2][2][4][2], const Unit& u, int wr, int wc, int fr, int fq) const {
        typedef unsigned u32x2v __attribute__((ext_vector_type(2)));
        const int row0 = u.pm * BM + wr * 64 + fr, col0 = u.pn * BM + wc * 32 + 4 * fq;
#pragma unroll
        for (int ai = 0; ai < 2; ++ai)
#pragma unroll
            for (int m = 0; m < 4; ++m) { const int r = row0 + ai * HALF + m * 16; const size_t off = (size_t)r * 1024 + col0; float s = 0.f;
#pragma unroll
                for (int bj = 0; bj < 2; ++bj)
#pragma unroll
                    for (int n = 0; n < 2; ++n) { const f32x4 b = *(const f32x4*)(base + off + bj * HALF + n * 16); const f32x4 o = b + acc[ai][bj][m][n];
                        *(f32x4*)(out + off + bj * HALF + n * 16) = o; s += (o[0] * o[0] + o[1] * o[1]) + (o[2] * o[2] + o[3] * o[3]);
                        u32x2v w; w.x = cvt_pk_bf16(o[0], o[1]); w.y = cvt_pk_bf16(o[2], o[3]); *(u32x2v*)(hb + off + bj * HALF + n * 16) = w; }
                s += __shfl_xor(s, 16); s += __shfl_xor(s, 32);
                if (fq == 0) ssq_out[(size_t)r * 16 + u.pn * 4 + wc] = s; }
    }
};
struct EpiUG {
    static constexpr bool PERM = true, AFTER_DRAIN = false;
    bf16_t* act; const float* ssq; const float* cw; const float* cb; float* fixb; PG8_LAS float* xch;
    __device__ __forceinline__ void operator()(f32x4 (&acc)[2][2][4][2], const Unit& u, int wr, int wc, int fr, int fq) const {
        const int row0 = u.pm * BM + wr * 64 + fr, lcol = wc * 32 + 8 * fq, fcol = u.pn * HALF + lcol;
        float rs[2][4]; load_rs(ssq, row0, fq, rs);
#pragma unroll
        for (int ai = 0; ai < 2; ++ai)
#pragma unroll
            for (int m = 0; m < 4; ++m)
#pragma unroll
                for (int bj = 0; bj < 2; ++bj)
#pragma unroll
                    for (int n = 0; n < 2; ++n) acc[ai][bj][m][n] = acc[ai][bj][m][n] * rs[ai][m];
        if (fr >= 14) {
#pragma unroll
            for (int ai = 0; ai < 2; ++ai) { const int q = 2 * ai + wr;
                if (q < 3) {
#pragma unroll
                    for (int n = 0; n < 2; ++n) *(PG8_LAS f32x4*)(xch + (q * 2 + (fr - 14)) * HALF + lcol + 4 * n) = acc[ai][0][3][n];
                } else {
#pragma unroll
                    for (int n = 0; n < 2; ++n) *(f32x4*)(fixb + ((size_t)u.pm * 6 + 4 + (fr - 14)) * 3072 + fcol + 4 * n) = acc[ai][0][3][n];
                } }
        }
        if (wr == 0 && fr < 2) {
#pragma unroll
            for (int n = 0; n < 2; ++n) { *(f32x4*)(fixb + ((size_t)u.pm * 6 + fr) * 3072 + fcol + 4 * n) = acc[0][0][0][n];
                                          *(f32x4*)(fixb + ((size_t)u.pm * 6 + 2 + fr) * 3072 + fcol + 4 * n) = acc[0][1][0][n]; }
        }
        asm volatile("s_waitcnt lgkmcnt(0)" ::: "memory"); __builtin_amdgcn_s_barrier(); asm volatile("" ::: "memory");
        typedef unsigned u32x2v __attribute__((ext_vector_type(2)));
#pragma unroll
        for (int n = 0; n < 2; ++n) {
            const f32x4 w0 = *(const f32x4*)(cw + fcol + 4 * n), w1 = *(const f32x4*)(cw + 3072 + fcol + 4 * n), w2 = *(const f32x4*)(cw + 6144 + fcol + 4 * n), bb = *(const f32x4*)(cb + fcol + 4 * n);
#pragma unroll
            for (int ai = 0; ai < 2; ++ai) { const int q = 2 * ai + wr;
                f32x4 B0 = (f32x4){0.f, 0.f, 0.f, 0.f}, B1 = B0;
                if (q > 0) { B0 = *(const PG8_LAS f32x4*)(xch + ((q - 1) * 2 + 0) * HALF + lcol + 4 * n); B1 = *(const PG8_LAS f32x4*)(xch + ((q - 1) * 2 + 1) * HALF + lcol + 4 * n); }
#pragma unroll
                for (int m = 0; m < 4; ++m) { f32x4 o;
#pragma unroll
                    for (int e = 0; e < 4; ++e) { const float cur = acc[ai][0][m][n][e];
                        float p1 = dpp_ror1(cur), p2 = dpp_ror2(cur), q1, q2;
                        if (m == 0) { q1 = B1[e]; q2 = (fr == 1) ? B1[e] : B0[e]; }
                        else { const float pv = acc[ai][0][m - 1][n][e]; q1 = dpp_ror1(pv); q2 = dpp_ror2(pv); }
                        p1 = (fr >= 1) ? p1 : q1; p2 = (fr >= 2) ? p2 : q2;
                        const float v = w0[e] * p2 + w1[e] * p1 + w2[e] * cur + bb[e];
                        o[e] = gelu_tanh(v) * acc[ai][1][m][n][e]; }
                    u32x2v w; w.x = cvt_pk_bf16(o[0], o[1]); w.y = cvt_pk_bf16(o[2], o[3]);
                    *(u32x2v*)(act + (size_t)(row0 + ai * HALF + m * 16) * 3072 + fcol + 4 * n) = w; } }
        }
    }
};

template <class Epi, class Sched, bool ALIGN_EPI = false, bool SP2 = false>
__device__ __forceinline__ void gemm_phase(PG8_LAS unsigned char* lds, const Gemm g, const Sched& S, const Epi& E) {
    int tid_o = threadIdx.x; asm volatile("" : "+v"(tid_o));
    const int tid = tid_o, wid = __builtin_amdgcn_readfirstlane(tid >> 6), lane = tid & 63, wr = wid >> 2, wc = wid & 3, fr = lane & 15, fq = lane >> 4;
    const int K = g.K, nt = K / BK;
    unsigned voffA[2], voffB[2];
#pragma unroll
    for (int i = 0; i < 2; ++i) { int R, C; stage_rc(tid * 16 + i * 8192, R, C); const int Rb = Epi::PERM ? ((R & ~31) + perm32(R & 31)) : R;
        voffA[i] = (unsigned)(R * K + C) * 2u; voffB[i] = (unsigned)(Rb * K + C) * 2u; }
    const size_t kstep = (size_t)(BK * 2);
    const size_t hstep = (size_t)HALF * K * 2;
    const size_t tstep = 2 * hstep;
    const unsigned ldsw = (unsigned)wid * 1024u;
    const int aoff = lds_byte(wr * 64 + fr, fq * 8), boff = lds_byte(wc * 32 + fr, fq * 8);
#define PG8_SA(b, h) (((b) * 2 + (h)) * HTB)
#define PG8_SB(b, h) ((4 + (b) * 2 + (h)) * HTB)
#define PG8_STAGE(bufoff, gbase, voff) do { _Pragma("unroll") for (int _i = 0; _i < 2; ++_i) \
        __builtin_amdgcn_global_load_lds((const unsigned*)((const char*)(gbase) + (voff)[_i]), (PG8_LAS unsigned*)(lds + (bufoff) + ldsw + _i * 8192), 16, 0, 0); } while (0)
#define PG8_LDA(dst, b, h) do { _Pragma("unroll") for (int m = 0; m < 4; ++m) _Pragma("unroll") for (int k = 0; k < 2; ++k) dst[m][k] = *(const PG8_LAS bf16x8*)(lds + PG8_SA(b, h) + aoff + m * 2048 + k * 1024); } while (0)
#define PG8_LDB(dst, b, h) do { _Pragma("unroll") for (int n = 0; n < 2; ++n) _Pragma("unroll") for (int k = 0; k < 2; ++k) dst[n][k] = *(const PG8_LAS bf16x8*)(lds + PG8_SB(b, h) + boff + n * 2048 + k * 1024); } while (0)
#define PG8_MMA(ai, bj, At, Bt) do { __builtin_amdgcn_s_setprio(1); _Pragma("unroll") for (int m = 0; m < 4; ++m) _Pragma("unroll") for (int n = 0; n < 2; ++n) _Pragma("unroll") for (int k = 0; k < 2; ++k) \
        acc[ai][bj][m][n] = __builtin_amdgcn_mfma_f32_16x16x32_bf16(Bt[n][k], At[m][k], acc[ai][bj][m][n], 0, 0, 0); __builtin_amdgcn_s_setprio(0); } while (0)
#define PG8_WAIT_V(n) asm volatile("s_waitcnt vmcnt(" #n ")" ::: "memory")
#define PG8_WAIT_L(n) asm volatile("s_waitcnt lgkmcnt(" #n ")" ::: "memory")
#define PG8_BAR __builtin_amdgcn_s_barrier()
#define PG8_SCHED __builtin_amdgcn_sched_barrier(0)
    Unit cur, nxt; int ui = 0;
    if (!S.next(0, cur)) return;
    f32x4 acc[2][2][4][2];
#pragma unroll
    for (int a = 0; a < 2; ++a)
#pragma unroll
        for (int b = 0; b < 2; ++b)
#pragma unroll
            for (int m = 0; m < 4; ++m)
#pragma unroll
                for (int n = 0; n < 2; ++n) acc[a][b][m][n] = (f32x4){0.f, 0.f, 0.f, 0.f};
    bf16x8 At[4][2], B0[2][2], B1[2][2];
    const char* cA = (const char*)g.A + (size_t)cur.pm * tstep; const char* cB = (const char*)g.Bt + (size_t)cur.pn * tstep;
    S.a_ready(cur);
    if constexpr (SP2) {
        PG8_STAGE(PG8_SB(0, 0), cB, voffB); PG8_STAGE(PG8_SB(0, 1), cB + hstep, voffB); PG8_STAGE(PG8_SA(0, 0), cA, voffA); PG8_STAGE(PG8_SA(0, 1), cA + hstep, voffA);
        if (wr == 1) PG8_BAR;
        PG8_WAIT_V(2); PG8_BAR;
        PG8_STAGE(PG8_SB(1, 0), cB + kstep, voffB); PG8_STAGE(PG8_SA(1, 0), cA + kstep, voffA); PG8_STAGE(PG8_SB(1, 1), cB + hstep + kstep, voffB);
        PG8_WAIT_V(6); PG8_BAR;
    } else {
        PG8_STAGE(PG8_SB(0, 0), cB, voffB); PG8_STAGE(PG8_SA(0, 0), cA, voffA); PG8_STAGE(PG8_SB(0, 1), cB + hstep, voffB); PG8_STAGE(PG8_SA(0, 1), cA + hstep, voffA);
        if (wr == 1) PG8_BAR;
        PG8_WAIT_V(4); PG8_BAR;
        PG8_STAGE(PG8_SB(1, 0), cB + kstep, voffB); PG8_STAGE(PG8_SA(1, 0), cA + kstep, voffA); PG8_STAGE(PG8_SB(1, 1), cB + hstep + kstep, voffB);
        PG8_WAIT_V(6); PG8_BAR;
    }
    for (;;) {
        const bool has_next = S.next(ui + 1, nxt);
        const char* nA = has_next ? (const char*)g.A + (size_t)nxt.pm * tstep : cA; const char* nB = has_next ? (const char*)g.Bt + (size_t)nxt.pn * tstep : cB;
        for (int t = 0; t < nt; t += 2) {
            const bool last = (t == nt - 2);
            const char* a1 = cA + (size_t)(t + 1) * kstep;
            const char* a2 = last ? nA : cA + (size_t)(t + 2) * kstep; const char* b2 = last ? nB : cB + (size_t)(t + 2) * kstep;
            const char* a3 = a2 + kstep; const char* b3 = b2 + kstep;
            if (last && has_next) S.a_ready(nxt);
            if constexpr (SP2) {
            PG8_LDB(B0, 0, 0); PG8_LDB(B1, 0, 1); PG8_SCHED; PG8_LDA(At, 0, 0); PG8_STAGE(PG8_SA(1, 1), a1 + hstep, voffA);
            PG8_WAIT_V(8); PG8_WAIT_L(0); PG8_BAR; PG8_MMA(0, 0, At, B0); PG8_MMA(0, 1, At, B1); PG8_BAR; PG8_SCHED;
            PG8_LDA(At, 0, 1); PG8_STAGE(PG8_SB(0, 0), b2, voffB); PG8_STAGE(PG8_SB(0, 1), b2 + hstep, voffB); PG8_STAGE(PG8_SA(0, 0), a2, voffA);
            PG8_WAIT_V(8); PG8_WAIT_L(0); PG8_BAR; PG8_MMA(1, 0, At, B0); PG8_MMA(1, 1, At, B1); PG8_BAR; PG8_SCHED;
            PG8_LDB(B0, 1, 0); PG8_LDB(B1, 1, 1); PG8_SCHED; PG8_LDA(At, 1, 0); PG8_STAGE(PG8_SA(0, 1), a2 + hstep, voffA);
            PG8_WAIT_V(8); PG8_WAIT_L(0); PG8_BAR; PG8_MMA(0, 0, At, B0); PG8_MMA(0, 1, At, B1); PG8_BAR; PG8_SCHED;
            PG8_LDA(At, 1, 1); PG8_STAGE(PG8_SB(1, 0), b3, voffB); PG8_STAGE(PG8_SB(1, 1), b3 + hstep, voffB); PG8_STAGE(PG8_SA(1, 0), a3, voffA);
            PG8_WAIT_V(8); PG8_WAIT_L(0); PG8_BAR; PG8_MMA(1, 0, At, B0); PG8_MMA(1, 1, At, B1); PG8_BAR; PG8_SCHED;
            } else {
            PG8_LDB(B0, 0, 0); PG8_SCHED; PG8_LDA(At, 0, 0); PG8_STAGE(PG8_SA(1, 1), a1 + hstep, voffA);
            PG8_WAIT_L(8); PG8_BAR; PG8_WAIT_L(0); PG8_MMA(0, 0, At, B0); PG8_BAR; PG8_SCHED;
            PG8_LDB(B1, 0, 1); PG8_STAGE(PG8_SB(0, 0), b2, voffB);
            PG8_BAR; PG8_WAIT_L(0); PG8_MMA(0, 1, At, B1); PG8_BAR;
            PG8_LDA(At, 0, 1); PG8_STAGE(PG8_SA(0, 0), a2, voffA);
            PG8_BAR; PG8_WAIT_L(0); PG8_MMA(1, 0, At, B0); PG8_BAR; PG8_SCHED;
            PG8_STAGE(PG8_SB(0, 1), b2 + hstep, voffB);
            PG8_WAIT_V(6); PG8_BAR; PG8_MMA(1, 1, At, B1); PG8_BAR;
            PG8_LDB(B0, 1, 0); PG8_SCHED; PG8_LDA(At, 1, 0); PG8_STAGE(PG8_SA(0, 1), a2 + hstep, voffA);
            PG8_WAIT_L(8); PG8_BAR; PG8_WAIT_L(0); PG8_MMA(0, 0, At, B0); PG8_BAR; PG8_SCHED;
            PG8_LDB(B1, 1, 1); PG8_STAGE(PG8_SB(1, 0), b3, voffB);
            PG8_BAR; PG8_WAIT_L(0); PG8_MMA(0, 1, At, B1); PG8_BAR;
            PG8_LDA(At, 1, 1); PG8_STAGE(PG8_SA(1, 0), a3, voffA);
            PG8_BAR; PG8_WAIT_L(0); PG8_MMA(1, 0, At, B0); PG8_BAR; PG8_SCHED;
            PG8_STAGE(PG8_SB(1, 1), b3 + hstep, voffB);
            PG8_WAIT_V(6); PG8_BAR; PG8_MMA(1, 1, At, B1); PG8_BAR;
            }
        }
        if constexpr (ALIGN_EPI) { if (wr == 0) PG8_BAR; }
        if constexpr (!Epi::AFTER_DRAIN) { E(acc, cur, wr, wc, fr, fq); S.done(cur); }
        if (!has_next) break;
#pragma unroll
        for (int a = 0; a < 2; ++a)
#pragma unroll
            for (int b = 0; b < 2; ++b)
#pragma unroll
                for (int m = 0; m < 4; ++m)
#pragma unroll
                    for (int n = 0; n < 2; ++n) acc[a][b][m][n] = (f32x4){0.f, 0.f, 0.f, 0.f};
        cur = nxt; cA = nA; cB = nB; ++ui;
        if constexpr (ALIGN_EPI) { if (wr == 1) PG8_BAR; }
    }
    PG8_WAIT_V(0);
    if constexpr (!ALIGN_EPI) { if (wr == 0) PG8_BAR; }
    PG8_BAR;
    if constexpr (Epi::AFTER_DRAIN) { E.fused(acc, cur, wr, wc, fr, fq, lds, wid, lane); S.done(cur); }
#undef PG8_SA
#undef PG8_SB
#undef PG8_STAGE
#undef PG8_LDA
#undef PG8_LDB
#undef PG8_MMA
#undef PG8_WAIT_V
#undef PG8_WAIT_L
#undef PG8_BAR
#undef PG8_SCHED
}
}
#include <hip/hip_cooperative_groups.h>
#ifndef MK_N_LAUNCHES
#define MK_N_LAUNCHES 30
#endif

constexpr int NWAVES = 8;
constexpr int DEPTH = 4, BATCH = 16, SEQ = 2048, D = 1024, INC = 2560, FF = 3072, LW = 512;
constexpr int M = BATCH * SEQ;
constexpr int CH = 64, NCH = SEQ / CH;
constexpr size_t MiB = 1u << 20;
constexpr size_t WS_CTL = 0, CTL_ZERO_BYTES = 64 * 1024;
constexpr size_t WS_WA = 2 * MiB, WS_WX = WS_WA + 512 * 1024;
constexpr size_t WS_SSQ1 = 3 * MiB, WS_SSQ2 = 5 * MiB;
constexpr size_t WS_EH = 7 * MiB, WS_EP = 8 * MiB;
constexpr size_t WS_FIX = 9 * MiB;
constexpr size_t WS_WIN = 20 * MiB, WS_WOUT = 40 * MiB, WS_WUG = 48 * MiB, WS_WDN = 96 * MiB;
constexpr size_t WS_HB = 120 * MiB, WS_Y = 184 * MiB, WS_PROJ = 248 * MiB, WS_ACT = 248 * MiB;
constexpr size_t WS_HLOC = 408 * MiB, WS_PCUM = 440 * MiB, WS_END = 472 * MiB;
static_assert(WS_FIX + (size_t)(M / 256) * 6 * FF * 4 <= WS_WIN && WS_PROJ + (size_t)M * INC * 2 <= WS_HLOC && WS_ACT + (size_t)M * FF * 2 <= WS_PCUM, "ws map");
constexpr int CW_BAR = 1024;
constexpr int RING_BYTES = 131072, XCH_OFF = RING_BYTES, MISC_OFF = XCH_OFF + 4096, LDS_BYTES = 147456;

#define GAS __attribute__((address_space(1)))
#define LAS __attribute__((address_space(3)))
typedef unsigned short bf16;
typedef unsigned v4u __attribute__((ext_vector_type(4)));
typedef float f32x4 __attribute__((ext_vector_type(4)));
typedef short bf16x8 __attribute__((ext_vector_type(8)));
typedef GAS unsigned gu32;
typedef GAS unsigned long long gu64;
#define RLX_AGENT __ATOMIC_RELAXED, __HIP_MEMORY_SCOPE_AGENT
#define LDS_WAIT() asm volatile("s_waitcnt lgkmcnt(0)" ::: "memory")
#define VM_WAIT() asm volatile("s_waitcnt vmcnt(0)" ::: "memory")
__device__ __forceinline__ unsigned long long rt() { return __builtin_amdgcn_s_memrealtime(); }
__device__ __forceinline__ unsigned f2bf(float f) { unsigned u = __builtin_bit_cast(unsigned, f); return (u + 0x7fffu + ((u >> 16) & 1u)) >> 16; }
__device__ __forceinline__ unsigned pk2(float lo, float hi) { return f2bf(lo) | (f2bf(hi) << 16); }

#define XB_TMO      128
#define XB_XCNT(j)  (256  + 64 * (j))
#define XB_XSUB(j)  (1280 + 64 * (j))
#define XB_XGEN(j)  (2304 + 64 * (j))
#define XB_TOP      3328
#define XB_TOPGEN   3392
#define XCD_BAR_WORDS 3456
#define XB_SPIN_CAP (1u << 18)

__device__ __forceinline__ unsigned xb_ld(unsigned* p)              { return __hip_atomic_load(p, __ATOMIC_RELAXED, __HIP_MEMORY_SCOPE_AGENT); }
__device__ __forceinline__ unsigned xb_add(unsigned* p, unsigned v) { return __hip_atomic_fetch_add(p, v, __ATOMIC_RELAXED, __HIP_MEMORY_SCOPE_AGENT); }
__device__ __forceinline__ unsigned xb_xcc_id() { return (unsigned)__builtin_amdgcn_s_getreg((3 << 11) | 20) & 0xFu; }
#define XB_SPIN(cond, bar) do { unsigned _sp = 0; while (cond) { __builtin_amdgcn_s_sleep(1); \
    if ((++_sp & 255u) == 0u) { if (xb_ld(&(bar)[XB_TMO])) break; if (_sp > XB_SPIN_CAP) { atomicAdd(&(bar)[XB_TMO], 1u); break; } } } } while (0)

struct XcdBarrier {
    unsigned* bar; unsigned x;
    volatile LAS unsigned* st;
};

__device__ __forceinline__ XcdBarrier xcd_barrier_post(unsigned* bar, volatile LAS unsigned* st) {
    XcdBarrier b; b.bar = bar; b.x = xb_xcc_id(); b.st = st;
    if (threadIdx.x == 0) (void)xb_add(&bar[XB_XCNT(b.x)], 1u);
    return b;
}
__device__ __forceinline__ void xcd_barrier_complete(unsigned* bar, unsigned x, unsigned& nloc, unsigned& nx) {
    const unsigned G = gridDim.x * gridDim.y * gridDim.z;
    unsigned sum, cnt, mine, sp = 0u;
    for (;;) {
        sum = 0u; cnt = 0u; mine = 0u;
#pragma unroll
        for (unsigned j = 0; j < 16; ++j) { const unsigned c = xb_ld(&bar[XB_XCNT(j)]); sum += c; cnt += (c > 0u) ? 1u : 0u; mine = (j == x) ? c : mine; }
        if (sum == G) break;
        __builtin_amdgcn_s_sleep(1);
        if ((++sp & 255u) == 0u) { if (xb_ld(&bar[XB_TMO])) break; if (sp > XB_SPIN_CAP) { atomicAdd(&bar[XB_TMO], 1u); break; } }
    }
    nloc = mine > 0u ? mine : 1u; nx = cnt > 0u ? cnt : 1u;
}

__device__ __forceinline__ void xcd_barrier(const XcdBarrier& b) {
    asm volatile("s_waitcnt vmcnt(0)" ::: "memory");
    __syncthreads();
    if (threadIdx.x == 0) {
        unsigned* bar = b.bar;
        __builtin_amdgcn_s_waitcnt(0);
        unsigned nloc = b.st[0], nx = b.st[1];
        if (nloc == 0u) { xcd_barrier_complete(bar, b.x, nloc, nx); b.st[0] = nloc; b.st[1] = nx; }
        const unsigned old = xb_add(&bar[XB_XSUB(b.x)], 1u);
        const unsigned gen = old / nloc;
        if (old + 1u == (gen + 1u) * nloc) {
            __builtin_amdgcn_fence(__ATOMIC_RELEASE, "agent");
            asm volatile("s_waitcnt vmcnt(0)" ::: "memory");
            const unsigned og = xb_add(&bar[XB_TOP], 1u);
            const unsigned tg = og / nx;
            if (og + 1u == (tg + 1u) * nx) xb_add(&bar[XB_TOPGEN], 1u);
            else XB_SPIN(xb_ld(&bar[XB_TOPGEN]) == tg, bar);
            __builtin_amdgcn_fence(__ATOMIC_ACQUIRE, "agent");
            xb_add(&bar[XB_XGEN(b.x)], 1u);
            asm volatile("s_waitcnt vmcnt(0)" ::: "memory");
        } else {
            XB_SPIN(xb_ld(&bar[XB_XGEN(b.x)]) == gen, bar);
            __builtin_amdgcn_fence(__ATOMIC_ACQUIRE, "agent");
            asm volatile("s_waitcnt vmcnt(0)" ::: "memory");
        }
    }
    __syncthreads();
}

struct Args {
    const float* x; const float* norm1_g; const float* w_in; const float* lru_conv_w; const float* lru_conv_b; const float* lru_w_a; const float* lru_b_a;
    const float* lru_w_x; const float* lru_b_x; const float* lru_lambda; const float* sc_conv_w; const float* lru_out_g; const float* sc_out_g; const float* w_out;
    const float* norm2_g; const float* mlp_w_up; const float* mlp_w_gate; const float* mlp_conv_w; const float* mlp_conv_b; const float* mlp_w_down; const float* final_g;
    float* out; unsigned char* ws; int ph_lo, ph_hi;
};
__device__ __forceinline__ float wave_sum(float v) {
#pragma unroll
    for (int o = 1; o < 64; o <<= 1) v += __shfl_xor(v, o);
    return v;
}
__device__ __forceinline__ float bf2f(unsigned short b) { return __builtin_bit_cast(float, (unsigned)b << 16); }
__device__ __forceinline__ float bflo(unsigned w) { return __builtin_bit_cast(float, w << 16); }
__device__ __forceinline__ float bfhi(unsigned w) { return __builtin_bit_cast(float, w & 0xffff0000u); }
__device__ __forceinline__ void unpack8(v4u w, float (&f)[8]) { f[0] = bflo(w.x); f[1] = bfhi(w.x); f[2] = bflo(w.y); f[3] = bfhi(w.y); f[4] = bflo(w.z); f[5] = bfhi(w.z); f[6] = bflo(w.w); f[7] = bfhi(w.w); }
__device__ __forceinline__ v4u pack8(const float (&f)[8]) { v4u w; w.x = pg8::cvt_pk_bf16(f[0], f[1]); w.y = pg8::cvt_pk_bf16(f[2], f[3]); w.z = pg8::cvt_pk_bf16(f[4], f[5]); w.w = pg8::cvt_pk_bf16(f[6], f[7]); return w; }

__device__ __forceinline__ void p0_transpose_item(const float* W, int K, int N, bf16* WT, int row_off, const float* gain, LAS float* scr, int item, int lane) {
    const int nblk = N / 32, kb = item / nblk, nb = item % nblk, k0 = 64 * kb, n0 = 32 * nb;
#pragma unroll 8
    for (int i = 0; i < 32; ++i) { const int kk = 2 * i + (lane >> 5); const float g = gain ? gain[k0 + kk] : 1.0f; scr[kk * 33 + (lane & 31)] = W[(size_t)(k0 + kk) * N + n0 + (lane & 31)] * g; }
    LDS_WAIT(); asm volatile("" ::: "memory");
    const int c = lane & 7;
#pragma unroll
    for (int j = 0; j < 4; ++j) { const int n = (lane >> 3) + 8 * j; const LAS float* s = scr + (8 * c) * 33 + n;
        v4u o; o.x = pk2(s[0 * 33], s[1 * 33]); o.y = pk2(s[2 * 33], s[3 * 33]); o.z = pk2(s[4 * 33], s[5 * 33]); o.w = pk2(s[6 * 33], s[7 * 33]);
        *(GAS v4u*)(WT + (size_t)(row_off + n0 + n) * K + k0 + 8 * c) = o; }
    LDS_WAIT(); asm volatile("" ::: "memory");
}
__device__ __forceinline__ void p0_transpose_item_ug(const float* W, bf16* WT, int half, const float* gain, LAS float* scr, int item, int lane) {
    constexpr int K = D, N = FF;
    const int nblk = N / 32, kb = item / nblk, nb = item % nblk, k0 = 64 * kb, n0 = 32 * nb;
#pragma unroll 8
    for (int i = 0; i < 32; ++i) { const int kk = 2 * i + (lane >> 5); const float g = gain[k0 + kk]; scr[kk * 33 + (lane & 31)] = W[(size_t)(k0 + kk) * N + n0 + (lane & 31)] * g; }
    LDS_WAIT(); asm volatile("" ::: "memory");
    const int c = lane & 7; const int rbase = 256 * (n0 / 128) + (n0 % 128) + 128 * half;
#pragma unroll
    for (int j = 0; j < 4; ++j) { const int n = (lane >> 3) + 8 * j; const LAS float* s = scr + (8 * c) * 33 + n;
        v4u o; o.x = pk2(s[0 * 33], s[1 * 33]); o.y = pk2(s[2 * 33], s[3 * 33]); o.z = pk2(s[4 * 33], s[5 * 33]); o.w = pk2(s[6 * 33], s[7 * 33]);
        *(GAS v4u*)(WT + (size_t)(rbase + n) * K + k0 + 8 * c) = o; }
    LDS_WAIT(); asm volatile("" ::: "memory");
}

__global__ void __launch_bounds__(NWAVES * 64, 2) mk_fwd(Args args) {
    extern __shared__ __attribute__((aligned(16))) unsigned char lds_raw[];
    LAS unsigned char* lds = (LAS unsigned char*)lds_raw;
    volatile LAS unsigned* MISC = (volatile LAS unsigned*)(lds + MISC_OFF);
    const int tid_k = threadIdx.x, lane_k = tid_k & 63, wave = __builtin_amdgcn_readfirstlane(tid_k >> 6);
    const int G = gridDim.x;
    const int vcu = (G % 8 == 0) ? ((int)blockIdx.x % 8) * (G / 8) + (int)blockIdx.x / 8 : (int)blockIdx.x;
    const int gw = vcu * NWAVES + wave, NGW = G * NWAVES;
    unsigned char* ws = args.ws;
    for (int u = tid_k; u < (LDS_BYTES - MISC_OFF) / 4; u += NWAVES * 64) ((LAS unsigned*)(lds + MISC_OFF))[u] = 0u;
    __syncthreads();
    XcdBarrier bar = xcd_barrier_post((unsigned*)(ws + WS_CTL) + CW_BAR, MISC + 8);
    bf16* Wa_t = (bf16*)(ws + WS_WA); bf16* Wx_t = (bf16*)(ws + WS_WX);
    float* ssq1 = (float*)(ws + WS_SSQ1); float* ssq2 = (float*)(ws + WS_SSQ2);
    float* Eh = (float*)(ws + WS_EH); float* EP = (float*)(ws + WS_EP); float* fixb = (float*)(ws + WS_FIX);
    bf16* Win_t = (bf16*)(ws + WS_WIN); bf16* Wout_t = (bf16*)(ws + WS_WOUT); bf16* Wug_t = (bf16*)(ws + WS_WUG); bf16* Wdn_t = (bf16*)(ws + WS_WDN);
    bf16* hb = (bf16*)(ws + WS_HB); bf16* yb = (bf16*)(ws + WS_Y); bf16* proj = (bf16*)(ws + WS_PROJ); bf16* act = (bf16*)(ws + WS_ACT);
    bf16* hloc = (bf16*)(ws + WS_HLOC); bf16* pcum = (bf16*)(ws + WS_PCUM);
    const int lo = args.ph_lo, hi = args.ph_hi;
    int ph = 0;
#define RUN(k) (lo <= (k) && (k) < hi)
#define SEAM(k) do { if (RUN(k) && RUN((k) + 1)) xcd_barrier(bar); } while (0)

    if (RUN(ph)) {
        int lane = lane_k; asm volatile("" : "+v"(lane));
        LAS float* scr = (LAS float*)(lds + wave * 16384);
        constexpr int I_IN = (D / 64) * (INC / 32), I_OUT = (D / 64) * (D / 32), I_UP = (D / 64) * (FF / 32), I_DN = (FF / 64) * (D / 32), I_G = 2;
        constexpr int PER_LAYER = I_IN + I_OUT + 2 * I_UP + I_DN + 8 * 2 * I_G;
        for (int it = gw; it < DEPTH * PER_LAYER; it += NGW) {
            const int l = it / PER_LAYER; int r = it % PER_LAYER;
            if (r < I_IN) { p0_transpose_item(args.w_in + (size_t)l * D * INC, D, INC, Win_t + (size_t)l * INC * D, 0, args.norm1_g + l * D, scr, r, lane); continue; } r -= I_IN;
            if (r < I_OUT) { const int kb = r / (D / 32); const float* g = (kb < 8) ? args.lru_out_g + l * LW + 0 : args.sc_out_g + l * LW - LW;
                p0_transpose_item(args.w_out + (size_t)l * D * D, D, D, Wout_t + (size_t)l * D * D, 0, g, scr, r, lane); continue; } r -= I_OUT;
            if (r < I_UP) { p0_transpose_item_ug(args.mlp_w_up + (size_t)l * D * FF, Wug_t + (size_t)l * 2 * FF * D, 0, args.norm2_g + l * D, scr, r, lane); continue; } r -= I_UP;
            if (r < I_UP) { p0_transpose_item_ug(args.mlp_w_gate + (size_t)l * D * FF, Wug_t + (size_t)l * 2 * FF * D, 1, args.norm2_g + l * D, scr, r, lane); continue; } r -= I_UP;
            if (r < I_DN) { p0_transpose_item(args.mlp_w_down + (size_t)l * FF * D, FF, D, Wdn_t + (size_t)l * D * FF, 0, nullptr, scr, r, lane); continue; } r -= I_DN;
            { const int hd = r / (2 * I_G), mat = (r / I_G) & 1, sub = r % I_G; const size_t o = ((size_t)l * 8 + hd) * 64 * 64;
              p0_transpose_item((mat ? args.lru_w_x : args.lru_w_a) + o, 64, 64, (mat ? Wx_t : Wa_t) + o, 0, nullptr, scr, sub, lane); }
        }
        for (int m = gw; m < M; m += NGW) {
            const GAS f32x4* xr = (const GAS f32x4*)(args.x + (size_t)m * D) + lane;
            f32x4 v[4]; float s = 0.f;
#pragma unroll
            for (int j = 0; j < 4; ++j) { v[j] = xr[64 * j]; s += (v[j].x * v[j].x + v[j].y * v[j].y) + (v[j].z * v[j].z + v[j].w * v[j].w); }
            s = wave_sum(s);
            GAS unsigned long long* o8 = (GAS unsigned long long*)(hb + (size_t)m * D) + lane;
#pragma unroll
            for (int j = 0; j < 4; ++j) o8[64 * j] = (unsigned long long)pg8::cvt_pk_bf16(v[j].x, v[j].y) | ((unsigned long long)pg8::cvt_pk_bf16(v[j].z, v[j].w) << 32);
            if (lane < 4) *(f32x4*)(ssq1 + (size_t)m * 16 + 4 * lane) = (f32x4){lane == 0 ? s : 0.f, 0.f, 0.f, 0.f};
        }
    }
    if (RUN(ph) && RUN(ph + 1)) { cooperative_groups::this_grid().sync(); }
    ++ph;

    for (int l = 0; l < DEPTH; ++l) {
        if (RUN(ph)) {
            pg8::Gemm g{hb, Win_t + (size_t)l * INC * D, M, INC, D}; pg8::StaticOrder S; S.init(M, INC, G, (int)blockIdx.x);
            pg8::EpiProj E{proj, INC, ssq1};
            pg8::gemm_phase<pg8::EpiProj, pg8::StaticOrder, true, true>(lds, g, S, E);
        }
        SEAM(ph); ++ph;
        if (RUN(ph)) {
            int lane = lane_k; asm volatile("" : "+v"(lane));
            const int fr = lane & 15, fq = lane >> 4, ch = 64 * wave + lane;
            LAS bf16* sA = (LAS bf16*)(lds + wave * 12288);
            LAS float* sR = (LAS float*)(lds + wave * 12288 + 2560);
            LAS float* sI = sR + 16 * 68;
            const float cw0 = args.lru_conv_w[(l * 4 + 0) * LW + ch], cw1 = args.lru_conv_w[(l * 4 + 1) * LW + ch], cw2 = args.lru_conv_w[(l * 4 + 2) * LW + ch], cw3 = args.lru_conv_w[(l * 4 + 3) * LW + ch];
            const float cbias = args.lru_conv_b[l * LW + ch], ba = args.lru_b_a[l * LW + ch], bx = args.lru_b_x[l * LW + ch];
            const float c2 = -8.0f * log1pf(__expf(-args.lru_lambda[l * LW + ch])) * 1.44269504089f;
            pg8::bf16x8 Ba[4][2], Bx[4][2];
#pragma unroll
            for (int nt = 0; nt < 4; ++nt)
#pragma unroll
                for (int ks = 0; ks < 2; ++ks) { const size_t o = (((size_t)l * 8 + wave) * 64 + 16 * nt + fr) * 64 + 32 * ks + 8 * fq;
                    Ba[nt][ks] = *(const pg8::bf16x8*)(Wa_t + o); Bx[nt][ks] = *(const pg8::bf16x8*)(Wx_t + o); }
            for (int item = vcu; item < BATCH * NCH; item += G) {
                const int b = item % BATCH, c = item / BATCH;
                const size_t t0 = (size_t)b * SEQ + (size_t)c * CH;
                float xm3 = 0.f, xm2 = 0.f, xm1 = 0.f;
                if (c > 0) { xm3 = bf2f(proj[(t0 - 3) * INC + ch]); xm2 = bf2f(proj[(t0 - 2) * INC + ch]); xm1 = bf2f(proj[(t0 - 1) * INC + ch]); }
                float h = 0.f, P = 1.f;
#pragma unroll 1
                for (int g = 0; g < CH / 16; ++g) {
                    const size_t tg = t0 + 16 * g;
                    float xa[16];
#pragma unroll
                    for (int j = 0; j < 16; ++j) { const float xv = bf2f(proj[(tg + j) * INC + ch]); xa[j] = cw0 * xm3 + cw1 * xm2 + cw2 * xm1 + cw3 * xv + cbias; xm3 = xm2; xm2 = xm1; xm1 = xv; }
#pragma unroll
                    for (int j = 0; j < 16; ++j) sA[j * 72 + lane] = (bf16)f2bf(xa[j]);
                    LDS_WAIT(); asm volatile("" ::: "memory");
                    const pg8::bf16x8 a0 = *(const LAS pg8::bf16x8*)(sA + fr * 72 + 8 * fq), a1 = *(const LAS pg8::bf16x8*)(sA + fr * 72 + 32 + 8 * fq);
                    f32x4 racc[4], iacc[4];
#pragma unroll
                    for (int nt = 0; nt < 4; ++nt) { racc[nt] = (f32x4){0.f, 0.f, 0.f, 0.f}; iacc[nt] = racc[nt];
                        racc[nt] = __builtin_amdgcn_mfma_f32_16x16x32_bf16(a0, Ba[nt][0], racc[nt], 0, 0, 0); racc[nt] = __builtin_amdgcn_mfma_f32_16x16x32_bf16(a1, Ba[nt][1], racc[nt], 0, 0, 0);
                        iacc[nt] = __builtin_amdgcn_mfma_f32_16x16x32_bf16(a0, Bx[nt][0], iacc[nt], 0, 0, 0); iacc[nt] = __builtin_amdgcn_mfma_f32_16x16x32_bf16(a1, Bx[nt][1], iacc[nt], 0, 0, 0); }
#pragma unroll
                    for (int nt = 0; nt < 4; ++nt)
#pragma unroll
                        for (int j = 0; j < 4; ++j) { sR[(4 * fq + j) * 68 + 16 * nt + fr] = racc[nt][j]; sI[(4 * fq + j) * 68 + 16 * nt + fr] = iacc[nt][j]; }
                    LDS_WAIT(); asm volatile("" ::: "memory");
#pragma unroll
                    for (int t = 0; t < 16; ++t) {
                        const float rp = sR[t * 68 + lane] + ba, ip = sI[t * 68 + lane] + bx;
                        const float r = __builtin_amdgcn_rcpf(1.0f + __builtin_amdgcn_exp2f(-1.44269504089f * rp));
                        const float ig = __builtin_amdgcn_rcpf(1.0f + __builtin_amdgcn_exp2f(-1.44269504089f * ip));
                        const float a = __builtin_amdgcn_exp2f(c2 * r);
                        const float mult = __builtin_amdgcn_sqrtf(fmaxf(1.0f - a * a, 0.f));
                        h = a * h + mult * ig * xa[t]; P *= a;
                        hloc[(tg + t) * LW + ch] = (bf16)f2bf(h); pcum[(tg + t) * LW + ch] = (bf16)f2bf(P);
                    }
                    LDS_WAIT(); asm volatile("" ::: "memory");
                }
                Eh[((size_t)b * NCH + c) * LW + ch] = h; EP[((size_t)b * NCH + c) * LW + ch] = P;
            }
        }
        SEAM(ph); ++ph;
        if (RUN(ph)) {
            int lane = lane_k; asm volatile("" : "+v"(lane));
            float w0[8], w1[8], w2[8];
#pragma unroll
            for (int e = 0; e < 8; ++e) { w0[e] = args.sc_conv_w[(l * 3 + 0) * LW + 8 * lane + e]; w1[e] = args.sc_conv_w[(l * 3 + 1) * LW + 8 * lane + e]; w2[e] = args.sc_conv_w[(l * 3 + 2) * LW + 8 * lane + e]; }
            for (int item = vcu; item < BATCH * NCH; item += G) {
                const int b = item % BATCH, c = item / BATCH;
                float H[8];
#pragma unroll
                for (int e = 0; e < 8; ++e) H[e] = 0.f;
                for (int j = 0; j < c; ++j) { const size_t o = ((size_t)b * NCH + j) * LW + 8 * lane;
                    const f32x4 p0 = *(const f32x4*)(EP + o), p1 = *(const f32x4*)(EP + o + 4), h0 = *(const f32x4*)(Eh + o), h1 = *(const f32x4*)(Eh + o + 4);
#pragma unroll
                    for (int e = 0; e < 4; ++e) { H[e] = p0[e] * H[e] + h0[e]; H[4 + e] = p1[e] * H[4 + e] + h1[e]; } }
                const int s0 = c * CH + 8 * wave;
                const size_t t0 = (size_t)b * SEQ + s0;
                float cv1[8], cv2[8];
#pragma unroll
                for (int e = 0; e < 8; ++e) { cv1[e] = 0.f; cv2[e] = 0.f; }
                if (s0 > 0) { float a[8], bq[8];
                    unpack8(*(const v4u*)(proj + (t0 - 1) * INC + 1536 + 8 * lane), a); unpack8(*(const v4u*)(proj + (t0 - 1) * INC + 2048 + 8 * lane), bq);
#pragma unroll
                    for (int e = 0; e < 8; ++e) cv1[e] = a[e] * bq[e];
                    unpack8(*(const v4u*)(proj + (t0 - 2) * INC + 1536 + 8 * lane), a); unpack8(*(const v4u*)(proj + (t0 - 2) * INC + 2048 + 8 * lane), bq);
#pragma unroll
                    for (int e = 0; e < 8; ++e) cv2[e] = a[e] * bq[e]; }
#pragma unroll 2
                for (int tt = 0; tt < 8; ++tt) {
                    const size_t t = t0 + tt;
                    float hl[8], pc[8], gt[8], sb[8], sc[8], sv[8], ya[8], yv[8];
                    unpack8(*(const v4u*)(hloc + t * LW + 8 * lane), hl); unpack8(*(const v4u*)(pcum + t * LW + 8 * lane), pc);
                    unpack8(*(const v4u*)(proj + t * INC + 512 + 8 * lane), gt); unpack8(*(const v4u*)(proj + t * INC + 1024 + 8 * lane), sb);
                    unpack8(*(const v4u*)(proj + t * INC + 1536 + 8 * lane), sc); unpack8(*(const v4u*)(proj + t * INC + 2048 + 8 * lane), sv);
                    float sa = 0.f, sbq = 0.f;
#pragma unroll
                    for (int e = 0; e < 8; ++e) { const float hh = hl[e] + pc[e] * H[e]; ya[e] = hh * pg8::gelu_tanh(gt[e]); sa += ya[e] * ya[e];
                        const float cv = sc[e] * sv[e]; yv[e] = sb[e] * (w0[e] * cv2[e] + w1[e] * cv1[e] + w2[e] * cv); sbq += yv[e] * yv[e]; cv2[e] = cv1[e]; cv1[e] = cv; }
                    sa = wave_sum(sa); sbq = wave_sum(sbq);
                    const float ra = __builtin_amdgcn_rsqf(sa * (1.0f / LW) + pg8::RMS_EPS), rb = __builtin_amdgcn_rsqf(sbq * (1.0f / LW) + pg8::RMS_EPS);
#pragma unroll
                    for (int e = 0; e < 8; ++e) { ya[e] *= ra; yv[e] *= rb; }
                    *(v4u*)(yb + t * D + 8 * lane) = pack8(ya); *(v4u*)(yb + t * D + LW + 8 * lane) = pack8(yv);
                }
            }
        }
        SEAM(ph); ++ph;
        if (RUN(ph)) {
            pg8::Gemm g{yb, Wout_t + (size_t)l * D * D, M, D, D}; pg8::StaticOrder S; S.init(M, D, G, (int)blockIdx.x);
            pg8::EpiRes E{l == 0 ? args.x : args.out, args.out, hb, ssq2};
            pg8::gemm_phase<pg8::EpiRes, pg8::StaticOrder, true, true>(lds, g, S, E);
        }
        SEAM(ph); ++ph;
        if (RUN(ph)) {
            pg8::Gemm g{hb, Wug_t + (size_t)l * 2 * FF * D, M, 2 * FF, D}; pg8::StaticOrder S; S.init(M, 2 * FF, G, (int)blockIdx.x);
            pg8::EpiUG E{act, ssq2, args.mlp_conv_w + (size_t)l * 3 * FF, args.mlp_conv_b + (size_t)l * FF, fixb, (LAS float*)(lds + XCH_OFF)};
            pg8::gemm_phase<pg8::EpiUG, pg8::StaticOrder, true, true>(lds, g, S, E);
        }
        SEAM(ph); ++ph;
        if (RUN(ph)) {
            const float* cw = args.mlp_conv_w + (size_t)l * 3 * FF; const float* cb = args.mlp_conv_b + (size_t)l * FF;
            int tid = tid_k; asm volatile("" : "+v"(tid));
            for (int i = vcu * (NWAVES * 64) + tid; i < (M / 256) * (FF / 4); i += G * NWAVES * 64) {
                const int pm = i / (FF / 4), f = 4 * (i % (FF / 4));
                const float* fb = fixb + (size_t)pm * 6 * FF + f;
                const f32x4 u0 = *(const f32x4*)(fb), u1 = *(const f32x4*)(fb + FF), g0 = *(const f32x4*)(fb + 2 * FF), g1 = *(const f32x4*)(fb + 3 * FF);
                f32x4 pm2 = (f32x4){0.f, 0.f, 0.f, 0.f}, pm1 = pm2;
                if (pm % (SEQ / 256) != 0) { pm2 = *(const f32x4*)(fb - 2 * FF); pm1 = *(const f32x4*)(fb - FF); }
                const f32x4 w0 = *(const f32x4*)(cw + f), w1 = *(const f32x4*)(cw + FF + f), w2 = *(const f32x4*)(cw + 2 * FF + f), bb = *(const f32x4*)(cb + f);
                float o0[4], o1[4];
#pragma unroll
                for (int e = 0; e < 4; ++e) { o0[e] = pg8::gelu_tanh(w0[e] * pm2[e] + w1[e] * pm1[e] + w2[e] * u0[e] + bb[e]) * g0[e];
                                              o1[e] = pg8::gelu_tanh(w0[e] * pm1[e] + w1[e] * u0[e] + w2[e] * u1[e] + bb[e]) * g1[e]; }
                typedef unsigned u32x2v __attribute__((ext_vector_type(2)));
                u32x2v a; a.x = pg8::cvt_pk_bf16(o0[0], o0[1]); a.y = pg8::cvt_pk_bf16(o0[2], o0[3]); *(u32x2v*)(act + (size_t)(pm * 256) * FF + f) = a;
                a.x = pg8::cvt_pk_bf16(o1[0], o1[1]); a.y = pg8::cvt_pk_bf16(o1[2], o1[3]); *(u32x2v*)(act + (size_t)(pm * 256 + 1) * FF + f) = a;
            }
        }
        SEAM(ph); ++ph;
        if (RUN(ph)) {
            pg8::Gemm g{act, Wdn_t + (size_t)l * D * FF, M, D, FF}; pg8::StaticOrder S; S.init(M, D, G, (int)blockIdx.x);
            pg8::EpiRes E{args.out, args.out, hb, ssq1};
            pg8::gemm_phase<pg8::EpiRes, pg8::StaticOrder, true, true>(lds, g, S, E);
        }
        SEAM(ph); ++ph;
    }
    if (RUN(ph)) {
        int lane = lane_k; asm volatile("" : "+v"(lane));
        f32x4 gf[4];
#pragma unroll
        for (int j = 0; j < 4; ++j) gf[j] = *((const f32x4*)args.final_g + lane + 64 * j);
        for (int m = gw; m < M; m += NGW) {
            const float pr = (lane < 16) ? ssq1[(size_t)m * 16 + lane] : 0.f;
            const float rs = __builtin_amdgcn_rsqf(wave_sum(pr) * (1.0f / D) + pg8::RMS_EPS);
            GAS f32x4* xr = (GAS f32x4*)(args.out + (size_t)m * D) + lane;
#pragma unroll
            for (int j = 0; j < 4; ++j) { f32x4 v = xr[64 * j]; v = v * rs * gf[j]; xr[64 * j] = v; }
        }
    }
#undef RUN
#undef SEAM
}
constexpr int N_PHASES = 2 + DEPTH * 7;

extern "C" void kernel_launch(void* const* d_in, const int* in_sizes, int n_in, void* d_out, int out_size, void* d_ws, size_t ws_size, hipStream_t stream) {
    static int grid = 0;
    if (grid == 0) {
        if (n_in != 21 || in_sizes[0] != M * D || out_size != M * D || ws_size < WS_END) { fprintf(stderr, "kernel_launch: unexpected shapes (n_in %d, in0 %d, out %d, ws %zu); nothing launched\n", n_in, n_in > 0 ? in_sizes[0] : -1, out_size, ws_size); grid = -1; return; }
        int dev = 0, cus = 0, per_cu = 0;
        if (hipGetDevice(&dev) != hipSuccess || hipDeviceGetAttribute(&cus, hipDeviceAttributeMultiprocessorCount, dev) != hipSuccess) { grid = -1; return; }
        if (hipFuncSetAttribute((const void*)mk_fwd, hipFuncAttributeMaxDynamicSharedMemorySize, LDS_BYTES) != hipSuccess) { fprintf(stderr, "kernel_launch: hipFuncSetAttribute failed\n"); grid = -1; return; }
        if (hipOccupancyMaxActiveBlocksPerMultiprocessor(&per_cu, (const void*)mk_fwd, NWAVES * 64, LDS_BYTES) != hipSuccess || per_cu < 1) { fprintf(stderr, "kernel_launch: occupancy query says %d\n", per_cu); per_cu = 1; }
        (void)hipGetLastError();
        grid = cus;
    }
    if (grid < 0) return;
    (void)hipMemsetAsync((char*)d_ws + WS_CTL, 0, CTL_ZERO_BYTES, stream);
    Args a{};
    const float** ap = (const float**)&a;
    for (int i = 0; i < 21; ++i) ap[i] = (const float*)d_in[i];
    a.out = (float*)d_out; a.ws = (unsigned char*)d_ws;
#if MK_N_LAUNCHES == 1
    a.ph_lo = 0; a.ph_hi = N_PHASES;
    void* kargs[] = {&a};
    hipError_t e = hipLaunchCooperativeKernel((const void*)mk_fwd, dim3(grid), dim3(NWAVES * 64), kargs, LDS_BYTES, stream);
    if (e != hipSuccess) fprintf(stderr, "kernel_launch: cooperative launch failed: %s (grid %d)\n", hipGetErrorString(e), grid);
#else
    for (int p = 0; p < N_PHASES; ++p) { a.ph_lo = p; a.ph_hi = p + 1; hipLaunchKernelGGL(mk_fwd, dim3(grid), dim3(NWAVES * 64), LDS_BYTES, stream, a); }
#endif
}
```

```cpp
#include <hip/hip_runtime.h>
#include <cstdio>
#include <cstdint>
namespace pg8 {
#define PG8_LAS __attribute__((address_space(3)))
typedef unsigned short bf16_t;
typedef short bf16x8 __attribute__((ext_vector_type(8)));
typedef float f32x4 __attribute__((ext_vector_type(4)));
typedef unsigned u32x4 __attribute__((ext_vector_type(4)));
constexpr int BM = 256, BK = 64, HALF = 128, HTB = HALF * BK * 2  , STAGE_BYTES = 8 * HTB, NXCD = 8, WGM = 8;

__host__ __device__ __forceinline__ int lds_byte(int r, int c) { const int st = (r >> 4) * 2 + (c >> 5), rr = r & 15, cc = c & 31, ob = rr * 64 + cc * 2; return st * 1024 + (ob ^ (((ob >> 9) & 1) << 5)); }
__host__ __device__ __forceinline__ void stage_rc(int b, int& R, int& C) { const int st = b / 1024, sb = b % 1024, swz = sb ^ (((sb >> 9) & 1) << 5); R = (st >> 1) * 16 + swz / 64; C = (st & 1) * 32 + (swz % 64) / 2; }
__host__ __device__ __forceinline__ int perm32(int rho) { const int n = rho >> 4, i = rho & 15; return 8 * (i >> 2) + 4 * n + (i & 3); }

struct Unit { int pm, pn; };
struct Gemm { const bf16_t* A; const bf16_t* Bt; int M, N, K; };

struct StaticOrder {
    int nM, nN, nwg, G, c, nx;
    __host__ __device__ void init(int M, int N, int G_, int c_, int nx_ = NXCD) { nM = M / BM; nN = N / BM; nwg = nM * nN; G = G_; c = c_; nx = nx_; }
    __host__ __device__ bool next(int i, Unit& u) const {
        const long L = (long)i * G + c; if (L >= nwg) return false;
        int wgid = (int)L; { const int q = nwg / nx, r = nwg % nx, xcd = wgid % nx, off = wgid / nx; wgid = (xcd < r ? xcd * (q + 1) : r * (q + 1) + (xcd - r) * q) + off; }
        const int nig = WGM * nN, gid = wgid / nig, fm = gid * WGM, gsz = (nM - fm) < WGM ? (nM - fm) : WGM;
        u.pm = fm + ((wgid % nig) % gsz); u.pn = (wgid % nig) / gsz; return true;
    }
    __device__ __forceinline__ void a_ready(const Unit&) const {}
    __device__ __forceinline__ void done(const Unit&) const {}
};

__device__ __forceinline__ unsigned cvt_pk_bf16(float lo, float hi) { unsigned r; asm volatile("v_cvt_pk_bf16_f32 %0, %1, %2" : "=v"(r) : "v"(lo), "v"(hi)); return r; }
typedef float f32x2 __attribute__((ext_vector_type(2)));
__device__ __forceinline__ f32x2 gelu_pk(f32x2 v) {
    const f32x2 av = __builtin_elementwise_abs(v), d = av * 0.2316418882f + 1.0f;
    f32x2 t; t.x = __builtin_amdgcn_rcpf(d.x); t.y = __builtin_amdgcn_rcpf(d.y);
    f32x2 q = t * 0.5307027145f + (-0.7265760135f); q = q * t + 0.7107068705f; q = q * t + (-0.142248368f); q = q * t + 0.127414796f; q = q * t;
    const f32x2 s = (v * v) * (-0.72134752044f);
    f32x2 e; e.x = __builtin_amdgcn_exp2f(s.x); e.y = __builtin_amdgcn_exp2f(s.y);
    const f32x2 m = v * (q * e), r = v - m;
    f32x2 o; o.x = v.x < 0.f ? m.x : r.x; o.y = v.y < 0.f ? m.y : r.y; return o;
}


constexpr float RMS_EPS = 1e-6f;
__device__ __forceinline__ float dpp_ror1(float v) { return __builtin_bit_cast(float, __builtin_amdgcn_update_dpp(0, __builtin_bit_cast(int, v), 0x121, 0xf, 0xf, false)); }
__device__ __forceinline__ float dpp_ror2(float v) { return __builtin_bit_cast(float, __builtin_amdgcn_update_dpp(0, __builtin_bit_cast(int, v), 0x122, 0xf, 0xf, false)); }
__device__ __forceinline__ float gelu_tanh(float x) {
    const float z = x * (1.0f + 0.044715f * x * x) * (-2.3022081985f);
    return x * __builtin_amdgcn_rcpf(1.0f + __builtin_amdgcn_exp2f(z));
}
__device__ __forceinline__ f32x2 gelu_tanh_pk(f32x2 v) {
    f32x2 t = v * v; t = t * (0.044715f * -2.3022081985f) + (-2.3022081985f);
    const f32x2 z = v * t; f32x2 e; e.x = __builtin_amdgcn_exp2f(z.x); e.y = __builtin_amdgcn_exp2f(z.y); e = e + 1.0f;
    f32x2 r; r.x = __builtin_amdgcn_rcpf(e.x); r.y = __builtin_amdgcn_rcpf(e.y); return v * r;
}
__device__ __forceinline__ void load_rs(const float* ssq, int r0, int fq, float (&rs)[2][4]) {
#pragma unroll
    for (int ai = 0; ai < 2; ++ai)
#pragma unroll
        for (int m = 0; m < 4; ++m) {
            const f32x4 p = *(const f32x4*)(ssq + (size_t)(r0 + ai * HALF + m * 16) * 16 + 4 * fq);
            float s = (p[0] + p[1]) + (p[2] + p[3]);
            s += __shfl_xor(s, 16); s += __shfl_xor(s, 32);
            rs[ai][m] = __builtin_amdgcn_rsqf(s * (1.0f / 1024.0f) + RMS_EPS);
        }
}
__device__ __forceinline__ bool get_rs(PG8_LAS float* xch, const float* ssq, int pm, int row0, int wr, int wc, int fr, int fq, float (&rs)[2][4]) {
    PG8_LAS float* rsbuf = xch + 1280; volatile PG8_LAS int* rstag = (volatile PG8_LAS int*)(xch + 1536);
    const bool miss = (rstag[0] != pm + 1);
    if (miss) { load_rs(ssq, row0, fq, rs);
        if (wc == 0 && fq == 0) {
#pragma unroll
            for (int ai = 0; ai < 2; ++ai)
#pragma unroll
                for (int m = 0; m < 4; ++m) rsbuf[ai * HALF + wr * 64 + m * 16 + fr] = rs[ai][m]; }
    } else {
#pragma unroll
        for (int ai = 0; ai < 2; ++ai)
#pragma unroll
            for (int m = 0; m < 4; ++m) rs[ai][m] = rsbuf[ai * HALF + wr * 64 + m * 16 + fr];
    }
    return miss;
}
struct EpiProj {
    static constexpr bool PERM = true, AFTER_DRAIN = false;
    bf16_t* O; int ldc; const float* ssq; int pn_prod; PG8_LAS float* xch;
    __device__ __forceinline__ void operator()(const f32x4 (&acc)[2][2][4][2], const Unit& u, int wr, int wc, int fr, int fq) const {
        const int row0 = u.pm * BM + wr * 64 + fr;
        float rs[2][4]; const bool miss = get_rs(xch, ssq, u.pm, row0, wr, wc, fr, fq, rs);
        if (u.pn < pn_prod) {
            const int col0 = u.pn * BM + wc * 32 + 8 * fq;
#pragma unroll
            for (int ai = 0; ai < 2; ++ai)
#pragma unroll
                for (int m = 0; m < 4; ++m) { bf16_t* rowp = O + (size_t)(row0 + ai * HALF + m * 16) * ldc + col0; const float s = rs[ai][m];
#pragma unroll
                    for (int bj = 0; bj < 2; ++bj) { const f32x4 v0 = acc[ai][bj][m][0] * s, v1 = acc[ai][bj][m][1] * s;
                        u32x4 w; w.x = cvt_pk_bf16(v0[0], v0[1]); w.y = cvt_pk_bf16(v0[2], v0[3]); w.z = cvt_pk_bf16(v1[0], v1[1]); w.w = cvt_pk_bf16(v1[2], v1[3]);
                        *(u32x4*)(rowp + bj * HALF) = w; } }
        } else {
            const int col0 = pn_prod * BM + (u.pn - pn_prod) * HALF + wc * 32 + 8 * fq;
#pragma unroll
            for (int ai = 0; ai < 2; ++ai)
#pragma unroll
                for (int m = 0; m < 4; ++m) { const float s2 = rs[ai][m] * rs[ai][m];
                    const f32x4 v0 = acc[ai][0][m][0] * acc[ai][1][m][0] * s2, v1 = acc[ai][0][m][1] * acc[ai][1][m][1] * s2;
                    u32x4 w; w.x = cvt_pk_bf16(v0[0], v0[1]); w.y = cvt_pk_bf16(v0[2], v0[3]); w.z = cvt_pk_bf16(v1[0], v1[1]); w.w = cvt_pk_bf16(v1[2], v1[3]);
                    *(u32x4*)(O + (size_t)(row0 + ai * HALF + m * 16) * ldc + col0) = w; }
        }
        if (miss) { asm volatile("s_waitcnt lgkmcnt(0)" ::: "memory"); __builtin_amdgcn_s_barrier(); asm volatile("" ::: "memory");
            if (wr == 0 && wc == 0 && fr == 0 && fq == 0) *(volatile PG8_LAS int*)(xch + 1536) = u.pm + 1; }
    }
};
struct EpiRes {
    static constexpr bool PERM = true, AFTER_DRAIN = false;
    bf16_t* hb; float* ssq_out;
    __device__ __forceinline__ void operator()(const f32x4 (&acc)[2][2][4][2], const Unit& u, int wr, int wc, int fr, int fq) const {
        const int row0 = u.pm * BM + wr * 64 + fr, col0 = u.pn * BM + wc * 32 + 8 * fq;
#pragma unroll
        for (int ai = 0; ai < 2; ++ai)
#pragma unroll
            for (int m = 0; m < 4; ++m) { const int r = row0 + ai * HALF + m * 16; bf16_t* rowp = hb + (size_t)r * 1024 + col0; float s = 0.f;
                u32x4 bq[2];
#pragma unroll
                for (int bj = 0; bj < 2; ++bj) bq[bj] = *(const u32x4*)(rowp + bj * HALF);
#pragma unroll
                for (int bj = 0; bj < 2; ++bj) { const u32x4 b = bq[bj]; const f32x4 a0 = acc[ai][bj][m][0], a1 = acc[ai][bj][m][1];
                    const float o0 = __builtin_bit_cast(float, b.x << 16) + a0[0], o1 = __builtin_bit_cast(float, b.x & 0xffff0000u) + a0[1], o2 = __builtin_bit_cast(float, b.y << 16) + a0[2], o3 = __builtin_bit_cast(float, b.y & 0xffff0000u) + a0[3];
                    const float o4 = __builtin_bit_cast(float, b.z << 16) + a1[0], o5 = __builtin_bit_cast(float, b.z & 0xffff0000u) + a1[1], o6 = __builtin_bit_cast(float, b.w << 16) + a1[2], o7 = __builtin_bit_cast(float, b.w & 0xffff0000u) + a1[3];
                    s += ((o0 * o0 + o1 * o1) + (o2 * o2 + o3 * o3)) + ((o4 * o4 + o5 * o5) + (o6 * o6 + o7 * o7));
                    u32x4 w; w.x = cvt_pk_bf16(o0, o1); w.y = cvt_pk_bf16(o2, o3); w.z = cvt_pk_bf16(o4, o5); w.w = cvt_pk_bf16(o6, o7);
                    *(u32x4*)(rowp + bj * HALF) = w; }
                s += __shfl_xor(s, 16); s += __shfl_xor(s, 32);
                if (fq == 0) ssq_out[(size_t)r * 16 + u.pn * 4 + wc] = s; }
    }
};
struct EpiUG {
    static constexpr bool PERM = true, AFTER_DRAIN = false;
    bf16_t* act; const float* ssq; const float* cw; const float* cb; float* fixb; PG8_LAS float* xch;
    __device__ __forceinline__ void operator()(f32x4 (&acc)[2][2][4][2], const Unit& u, int wr, int wc, int fr, int fq) const {
        const int row0 = u.pm * BM + wr * 64 + fr, lcol = wc * 32 + 8 * fq, fcol = u.pn * HALF + lcol;
        PG8_LAS float* wts = xch + 768;
        const int tid_e = (wr * 4 + wc) * 64 + fq * 16 + fr;
        const float wv = (tid_e < 384) ? cw[(tid_e >> 7) * 3072 + u.pn * HALF + (tid_e & 127)] : cb[u.pn * HALF + (tid_e & 127)];
        float rs[2][4]; const bool miss = get_rs(xch, ssq, u.pm, row0, wr, wc, fr, fq, rs);
#pragma unroll
        for (int ai = 0; ai < 2; ++ai)
#pragma unroll
            for (int m = 0; m < 4; ++m)
#pragma unroll
                for (int bj = 0; bj < 2; ++bj)
#pragma unroll
                    for (int n = 0; n < 2; ++n) acc[ai][bj][m][n] = acc[ai][bj][m][n] * rs[ai][m];
        if (fr >= 14) {
#pragma unroll
            for (int ai = 0; ai < 2; ++ai) { const int q = 2 * ai + wr;
                if (q < 3) {
#pragma unroll
                    for (int n = 0; n < 2; ++n) *(PG8_LAS f32x4*)(xch + (q * 2 + (fr - 14)) * HALF + lcol + 4 * n) = acc[ai][0][3][n];
                } else {
#pragma unroll
                    for (int n = 0; n < 2; ++n) *(f32x4*)(fixb + ((size_t)u.pm * 6 + 4 + (fr - 14)) * 3072 + fcol + 4 * n) = acc[ai][0][3][n];
                } }
        }
        if (wr == 0 && fr < 2) {
#pragma unroll
            for (int n = 0; n < 2; ++n) { *(f32x4*)(fixb + ((size_t)u.pm * 6 + fr) * 3072 + fcol + 4 * n) = acc[0][0][0][n];
                                          *(f32x4*)(fixb + ((size_t)u.pm * 6 + 2 + fr) * 3072 + fcol + 4 * n) = acc[0][1][0][n]; }
        }
        wts[tid_e] = wv;
        asm volatile("s_waitcnt lgkmcnt(0)" ::: "memory"); __builtin_amdgcn_s_barrier(); asm volatile("" ::: "memory");
        if (miss && tid_e == 0) *(volatile PG8_LAS int*)(xch + 1536) = u.pm + 1;
        typedef unsigned u32x2v __attribute__((ext_vector_type(2)));
        u32x2v wlo[2][4];
#pragma unroll
        for (int n = 0; n < 2; ++n) {
            const f32x4 w0 = *(const PG8_LAS f32x4*)(wts + lcol + 4 * n), w1 = *(const PG8_LAS f32x4*)(wts + 128 + lcol + 4 * n), w2 = *(const PG8_LAS f32x4*)(wts + 256 + lcol + 4 * n), bb = *(const PG8_LAS f32x4*)(wts + 384 + lcol + 4 * n);
#pragma unroll
            for (int ai = 0; ai < 2; ++ai) { const int q = 2 * ai + wr;
                f32x4 B0 = (f32x4){0.f, 0.f, 0.f, 0.f}, B1 = B0;
                if (q > 0) { B0 = *(const PG8_LAS f32x4*)(xch + ((q - 1) * 2 + 0) * HALF + lcol + 4 * n); B1 = *(const PG8_LAS f32x4*)(xch + ((q - 1) * 2 + 1) * HALF + lcol + 4 * n); }
                f32x4 R1p = B1, R2p;
#pragma unroll
                for (int e = 0; e < 4; ++e) R2p[e] = (fr == 1) ? B1[e] : B0[e];
#pragma unroll
                for (int m = 0; m < 4; ++m) { const f32x4 cur = acc[ai][0][m][n], gt = acc[ai][1][m][n]; f32x4 R1, R2, p1, p2;
#pragma unroll
                    for (int e = 0; e < 4; ++e) { R1[e] = dpp_ror1(cur[e]); R2[e] = dpp_ror2(cur[e]); p1[e] = (fr >= 1) ? R1[e] : R1p[e]; p2[e] = (fr >= 2) ? R2[e] : R2p[e]; }
                    R1p = R1; R2p = R2;
                    const f32x2 va = (f32x2){w0[0], w0[1]} * (f32x2){p2[0], p2[1]} + (f32x2){w1[0], w1[1]} * (f32x2){p1[0], p1[1]} + (f32x2){w2[0], w2[1]} * (f32x2){cur[0], cur[1]} + (f32x2){bb[0], bb[1]};
                    const f32x2 vb = (f32x2){w0[2], w0[3]} * (f32x2){p2[2], p2[3]} + (f32x2){w1[2], w1[3]} * (f32x2){p1[2], p1[3]} + (f32x2){w2[2], w2[3]} * (f32x2){cur[2], cur[3]} + (f32x2){bb[2], bb[3]};
                    const f32x2 oa = gelu_tanh_pk(va) * (f32x2){gt[0], gt[1]}, ob = gelu_tanh_pk(vb) * (f32x2){gt[2], gt[3]};
                    u32x2v w; w.x = cvt_pk_bf16(oa.x, oa.y); w.y = cvt_pk_bf16(ob.x, ob.y);
                    if (n == 0) wlo[ai][m] = w;
                    else { u32x4 w4; w4.x = wlo[ai][m].x; w4.y = wlo[ai][m].y; w4.z = w.x; w4.w = w.y; *(u32x4*)(act + (size_t)(row0 + ai * HALF + m * 16) * 3072 + fcol) = w4; } } }
        }
    }
};

template <class Epi, class Sched, bool ALIGN_EPI = false, bool SP2 = false>
__device__ __forceinline__ void gemm_phase(PG8_LAS unsigned char* lds, const Gemm g, const Sched& S, const Epi& E) {
    int tid_o = threadIdx.x; asm volatile("" : "+v"(tid_o));
    const int tid = tid_o, wid = __builtin_amdgcn_readfirstlane(tid >> 6), lane = tid & 63, wr = wid >> 2, wc = wid & 3, fr = lane & 15, fq = lane >> 4;
    const int K = g.K, nt = K / BK;
    unsigned voffA[2], voffB[2];
#pragma unroll
    for (int i = 0; i < 2; ++i) { int R, C; stage_rc(tid * 16 + i * 8192, R, C); const int Rb = Epi::PERM ? ((R & ~31) + perm32(R & 31)) : R;
        voffA[i] = (unsigned)(R * K + C) * 2u; voffB[i] = (unsigned)(Rb * K + C) * 2u; }
    const size_t kstep = (size_t)(BK * 2);
    const size_t hstep = (size_t)HALF * K * 2;
    const size_t tstep = 2 * hstep;
    const unsigned ldsw = (unsigned)wid * 1024u;
    const int aoff = lds_byte(wr * 64 + fr, fq * 8), boff = lds_byte(wc * 32 + fr, fq * 8);
#define PG8_SA(b, h) (((b) * 2 + (h)) * HTB)
#define PG8_SB(b, h) ((4 + (b) * 2 + (h)) * HTB)
#define PG8_STAGE(bufoff, gbase, voff) do { _Pragma("unroll") for (int _i = 0; _i < 2; ++_i) \
        __builtin_amdgcn_global_load_lds((const unsigned*)((const char*)(gbase) + (voff)[_i]), (PG8_LAS unsigned*)(lds + (bufoff) + ldsw + _i * 8192), 16, 0, 0); } while (0)
#define PG8_LDA(dst, b, h) do { _Pragma("unroll") for (int m = 0; m < 4; ++m) _Pragma("unroll") for (int k = 0; k < 2; ++k) dst[m][k] = *(const PG8_LAS bf16x8*)(lds + PG8_SA(b, h) + aoff + m * 2048 + k * 1024); } while (0)
#define PG8_LDB(dst, b, h) do { _Pragma("unroll") for (int n = 0; n < 2; ++n) _Pragma("unroll") for (int k = 0; k < 2; ++k) dst[n][k] = *(const PG8_LAS bf16x8*)(lds + PG8_SB(b, h) + boff + n * 2048 + k * 1024); } while (0)
#define PG8_MMA(ai, bj, At, Bt) do { __builtin_amdgcn_s_setprio(1); _Pragma("unroll") for (int m = 0; m < 4; ++m) _Pragma("unroll") for (int n = 0; n < 2; ++n) _Pragma("unroll") for (int k = 0; k < 2; ++k) \
        acc[ai][bj][m][n] = __builtin_amdgcn_mfma_f32_16x16x32_bf16(Bt[n][k], At[m][k], acc[ai][bj][m][n], 0, 0, 0); __builtin_amdgcn_s_setprio(0); } while (0)
#define PG8_WAIT_V(n) asm volatile("s_waitcnt vmcnt(" #n ")" ::: "memory")
#define PG8_WAIT_L(n) asm volatile("s_waitcnt lgkmcnt(" #n ")" ::: "memory")
#define PG8_BAR __builtin_amdgcn_s_barrier()
#define PG8_SCHED __builtin_amdgcn_sched_barrier(0)
    Unit cur, nxt; int ui = 0;
    if (!S.next(0, cur)) return;
    f32x4 acc[2][2][4][2];
#pragma unroll
    for (int a = 0; a < 2; ++a)
#pragma unroll
        for (int b = 0; b < 2; ++b)
#pragma unroll
            for (int m = 0; m < 4; ++m)
#pragma unroll
                for (int n = 0; n < 2; ++n) acc[a][b][m][n] = (f32x4){0.f, 0.f, 0.f, 0.f};
    bf16x8 At[4][2], B0[2][2], B1[2][2];
    const char* cA = (const char*)g.A + (size_t)cur.pm * tstep; const char* cB = (const char*)g.Bt + (size_t)cur.pn * tstep;
    S.a_ready(cur);
    if constexpr (SP2) {
        PG8_STAGE(PG8_SB(0, 0), cB, voffB); PG8_STAGE(PG8_SB(0, 1), cB + hstep, voffB); PG8_STAGE(PG8_SA(0, 0), cA, voffA); PG8_STAGE(PG8_SA(0, 1), cA + hstep, voffA);
        if (wr == 1) PG8_BAR;
        PG8_WAIT_V(2); PG8_BAR;
        PG8_STAGE(PG8_SB(1, 0), cB + kstep, voffB); PG8_STAGE(PG8_SA(1, 0), cA + kstep, voffA); PG8_STAGE(PG8_SB(1, 1), cB + hstep + kstep, voffB);
        PG8_WAIT_V(6); PG8_BAR;
    } else {
        PG8_STAGE(PG8_SB(0, 0), cB, voffB); PG8_STAGE(PG8_SA(0, 0), cA, voffA); PG8_STAGE(PG8_SB(0, 1), cB + hstep, voffB); PG8_STAGE(PG8_SA(0, 1), cA + hstep, voffA);
        if (wr == 1) PG8_BAR;
        PG8_WAIT_V(4); PG8_BAR;
        PG8_STAGE(PG8_SB(1, 0), cB + kstep, voffB); PG8_STAGE(PG8_SA(1, 0), cA + kstep, voffA); PG8_STAGE(PG8_SB(1, 1), cB + hstep + kstep, voffB);
        PG8_WAIT_V(6); PG8_BAR;
    }
    for (;;) {
        const bool has_next = S.next(ui + 1, nxt);
        const char* nA = has_next ? (const char*)g.A + (size_t)nxt.pm * tstep : cA; const char* nB = has_next ? (const char*)g.Bt + (size_t)nxt.pn * tstep : cB;
        for (int t = 0; t < nt; t += 2) {
            const bool last = (t == nt - 2);
            const char* a1 = cA + (size_t)(t + 1) * kstep;
            const char* a2 = last ? nA : cA + (size_t)(t + 2) * kstep; const char* b2 = last ? nB : cB + (size_t)(t + 2) * kstep;
            const char* a3 = a2 + kstep; const char* b3 = b2 + kstep;
            if (last && has_next) S.a_ready(nxt);
            if constexpr (SP2) {
            PG8_LDB(B0, 0, 0); PG8_LDB(B1, 0, 1); PG8_SCHED; PG8_LDA(At, 0, 0); PG8_STAGE(PG8_SA(1, 1), a1 + hstep, voffA);
            PG8_WAIT_V(8); PG8_WAIT_L(0); PG8_BAR; PG8_MMA(0, 0, At, B0); PG8_MMA(0, 1, At, B1); PG8_BAR; PG8_SCHED;
            PG8_LDA(At, 0, 1); PG8_STAGE(PG8_SB(0, 0), b2, voffB); PG8_STAGE(PG8_SB(0, 1), b2 + hstep, voffB); PG8_STAGE(PG8_SA(0, 0), a2, voffA);
            PG8_WAIT_V(8); PG8_WAIT_L(0); PG8_BAR; PG8_MMA(1, 0, At, B0); PG8_MMA(1, 1, At, B1); PG8_BAR; PG8_SCHED;
            PG8_LDB(B0, 1, 0); PG8_LDB(B1, 1, 1); PG8_SCHED; PG8_LDA(At, 1, 0); PG8_STAGE(PG8_SA(0, 1), a2 + hstep, voffA);
            PG8_WAIT_V(8); PG8_WAIT_L(0); PG8_BAR; PG8_MMA(0, 0, At, B0); PG8_MMA(0, 1, At, B1); PG8_BAR; PG8_SCHED;
            PG8_LDA(At, 1, 1); PG8_STAGE(PG8_SB(1, 0), b3, voffB); PG8_STAGE(PG8_SB(1, 1), b3 + hstep, voffB); PG8_STAGE(PG8_SA(1, 0), a3, voffA);
            PG8_WAIT_V(8); PG8_WAIT_L(0); PG8_BAR; PG8_MMA(1, 0, At, B0); PG8_MMA(1, 1, At, B1); PG8_BAR; PG8_SCHED;
            } else {
            PG8_LDB(B0, 0, 0); PG8_SCHED; PG8_LDA(At, 0, 0); PG8_STAGE(PG8_SA(1, 1), a1 + hstep, voffA);
            PG8_WAIT_L(8); PG8_BAR; PG8_WAIT_L(0); PG8_MMA(0, 0, At, B0); PG8_BAR; PG8_SCHED;
            PG8_LDB(B1, 0, 1); PG8_STAGE(PG8_SB(0, 0), b2, voffB);
            PG8_BAR; PG8_WAIT_L(0); PG8_MMA(0, 1, At, B1); PG8_BAR;
            PG8_LDA(At, 0, 1); PG8_STAGE(PG8_SA(0, 0), a2, voffA);
            PG8_BAR; PG8_WAIT_L(0); PG8_MMA(1, 0, At, B0); PG8_BAR; PG8_SCHED;
            PG8_STAGE(PG8_SB(0, 1), b2 + hstep, voffB);
            PG8_WAIT_V(6); PG8_BAR; PG8_MMA(1, 1, At, B1); PG8_BAR;
            PG8_LDB(B0, 1, 0); PG8_SCHED; PG8_LDA(At, 1, 0); PG8_STAGE(PG8_SA(0, 1), a2 + hstep, voffA);
            PG8_WAIT_L(8); PG8_BAR; PG8_WAIT_L(0); PG8_MMA(0, 0, At, B0); PG8_BAR; PG8_SCHED;
            PG8_LDB(B1, 1, 1); PG8_STAGE(PG8_SB(1, 0), b3, voffB);
            PG8_BAR; PG8_WAIT_L(0); PG8_MMA(0, 1, At, B1); PG8_BAR;
            PG8_LDA(At, 1, 1); PG8_STAGE(PG8_SA(1, 0), a3, voffA);
            PG8_BAR; PG8_WAIT_L(0); PG8_MMA(1, 0, At, B0); PG8_BAR; PG8_SCHED;
            PG8_STAGE(PG8_SB(1, 1), b3 + hstep, voffB);
            PG8_WAIT_V(6); PG8_BAR; PG8_MMA(1, 1, At, B1); PG8_BAR;
            }
        }
        if constexpr (ALIGN_EPI) { if (wr == 0) PG8_BAR; }
        if constexpr (!Epi::AFTER_DRAIN) { E(acc, cur, wr, wc, fr, fq); S.done(cur); }
        if (!has_next) break;
#pragma unroll
        for (int a = 0; a < 2; ++a)
#pragma unroll
            for (int b = 0; b < 2; ++b)
#pragma unroll
                for (int m = 0; m < 4; ++m)
#pragma unroll
                    for (int n = 0; n < 2; ++n) acc[a][b][m][n] = (f32x4){0.f, 0.f, 0.f, 0.f};
        cur = nxt; cA = nA; cB = nB; ++ui;
        if constexpr (ALIGN_EPI) { if (wr == 1) PG8_BAR; }
    }
    PG8_WAIT_V(0);
    if constexpr (!ALIGN_EPI) { if (wr == 0) PG8_BAR; }
    PG8_BAR;
    if constexpr (Epi::AFTER_DRAIN) { E.fused(acc, cur, wr, wc, fr, fq, lds, wid, lane); S.done(cur); }
#undef PG8_SA
#undef PG8_SB
#undef PG8_STAGE
#undef PG8_LDA
#undef PG8_LDB
#undef PG8_MMA
#undef PG8_WAIT_V
#undef PG8_WAIT_L
#undef PG8_BAR
#undef PG8_SCHED
}
}
#include <hip/hip_cooperative_groups.h>
#ifndef PROBE_DUP
#define PROBE_DUP 0
#endif
#define REP(bit) for (int rep_ = 0; rep_ < ((PROBE_DUP & (bit)) ? 2 : 1); ++rep_)
#ifndef MK_N_LAUNCHES
#define MK_N_LAUNCHES 1
#endif

constexpr int NWAVES = 8;
constexpr int DEPTH = 4, BATCH = 16, SEQ = 2048, D = 1024, INC = 2560, FF = 3072, LW = 512;
constexpr int PW = 2048;
constexpr int M = BATCH * SEQ;
constexpr int NG = 4, GX = 8 / NG;
constexpr int BH = BATCH / NG, MH = M / NG;
constexpr int CH = 64, NCH = SEQ / CH;
constexpr size_t MiB = 1u << 20;
constexpr size_t WS_CTL = 0, CTL_ZERO_BYTES = 64 * 1024;
constexpr size_t WS_WA = 2 * MiB, WS_WX = WS_WA + 512 * 1024;
constexpr size_t WS_SSQ1 = 3 * MiB, WS_SSQ2 = 5 * MiB;
constexpr size_t WS_EH = 7 * MiB, WS_EP = 8 * MiB;
constexpr size_t WS_FIX = 9 * MiB;
constexpr size_t WS_WIN = 20 * MiB, WS_WOUT = 40 * MiB, WS_WUG = 48 * MiB, WS_WDN = 96 * MiB;
constexpr size_t WS_HB = 120 * MiB, WS_Y = 184 * MiB, WS_R = 248 * MiB, R_HALF = (192 / NG) * MiB;
constexpr size_t R_HLOC = (128 / NG) * MiB, R_PCUM = (160 / NG) * MiB, WS_END = WS_R + NG * R_HALF;
static_assert(WS_FIX + (size_t)(M / 256) * 6 * FF * 4 <= WS_WIN && (size_t)MH * PW * 2 <= R_HLOC && R_HLOC + (size_t)MH * LW * 2 <= R_PCUM && R_PCUM + (size_t)MH * LW * 2 <= R_HALF && (size_t)MH * FF * 2 <= R_HALF, "ws map");
constexpr int CW_BAR = 1024;
constexpr int CW_FLAG = 15360;
constexpr int RING_BYTES = 131072, XCH_OFF = RING_BYTES, MISC_OFF = XCH_OFF + 8192, LDS_BYTES = 147456;

#define GAS __attribute__((address_space(1)))
#define LAS __attribute__((address_space(3)))
typedef unsigned short bf16;
typedef unsigned v4u __attribute__((ext_vector_type(4)));
typedef float f32x4 __attribute__((ext_vector_type(4)));
typedef short bf16x8 __attribute__((ext_vector_type(8)));
typedef GAS unsigned gu32;
typedef GAS unsigned long long gu64;
#define RLX_AGENT __ATOMIC_RELAXED, __HIP_MEMORY_SCOPE_AGENT
#define LDS_WAIT() asm volatile("s_waitcnt lgkmcnt(0)" ::: "memory")
#define VM_WAIT() asm volatile("s_waitcnt vmcnt(0)" ::: "memory")
__device__ __forceinline__ unsigned long long rt() { return __builtin_amdgcn_s_memrealtime(); }
__device__ __forceinline__ unsigned f2bf(float f) { unsigned u = __builtin_bit_cast(unsigned, f); return (u + 0x7fffu + ((u >> 16) & 1u)) >> 16; }
__device__ __forceinline__ unsigned pk2(float lo, float hi) { return f2bf(lo) | (f2bf(hi) << 16); }

#define XB_TMO      128
#define XB_XCNT(j)  (256  + 64 * (j))
#define XB_XSUB(j)  (1280 + 64 * (j))
#define XB_XGEN(j)  (2304 + 64 * (j))
#define XB_TOP      3328
#define XB_TOPGEN   3392
#define XCD_BAR_WORDS 3456
#define XB_SPIN_CAP (1u << 18)

__device__ __forceinline__ unsigned xb_ld(unsigned* p)              { return __hip_atomic_load(p, __ATOMIC_RELAXED, __HIP_MEMORY_SCOPE_AGENT); }
__device__ __forceinline__ unsigned xb_add(unsigned* p, unsigned v) { return __hip_atomic_fetch_add(p, v, __ATOMIC_RELAXED, __HIP_MEMORY_SCOPE_AGENT); }
__device__ __forceinline__ unsigned xb_xcc_id() { return (unsigned)__builtin_amdgcn_s_getreg((3 << 11) | 20) & 0xFu; }
#define XB_SPIN(cond, bar) do { unsigned _sp = 0; while (cond) { __builtin_amdgcn_s_sleep(1); \
    if ((++_sp & 255u) == 0u) { if (xb_ld(&(bar)[XB_TMO])) break; if (_sp > XB_SPIN_CAP) { atomicAdd(&(bar)[XB_TMO], 1u); break; } } } } while (0)

struct XcdBarrier {
    unsigned* bar; unsigned x;
    volatile LAS unsigned* st;
    unsigned expect;
};

__device__ __forceinline__ XcdBarrier xcd_barrier_post(unsigned* bar, volatile LAS unsigned* st, unsigned expect) {
    XcdBarrier b; b.bar = bar; b.x = xb_xcc_id(); b.st = st; b.expect = expect;
    if (threadIdx.x == 0) (void)xb_add(&bar[XB_XCNT(b.x)], 1u);
    return b;
}
__device__ __forceinline__ void xcd_barrier_complete(unsigned* bar, unsigned x, unsigned& nloc, unsigned& nx, unsigned G) {
    unsigned sum, cnt, mine, sp = 0u;
    for (;;) {
        sum = 0u; cnt = 0u; mine = 0u;
#pragma unroll
        for (unsigned j = 0; j < 16; ++j) { const unsigned c = xb_ld(&bar[XB_XCNT(j)]); sum += c; cnt += (c > 0u) ? 1u : 0u; mine = (j == x) ? c : mine; }
        if (sum == G) break;
        __builtin_amdgcn_s_sleep(1);
        if ((++sp & 255u) == 0u) { if (xb_ld(&bar[XB_TMO])) break; if (sp > XB_SPIN_CAP) { atomicAdd(&bar[XB_TMO], 1u); break; } }
    }
    nloc = mine > 0u ? mine : 1u; nx = cnt > 0u ? cnt : 1u;
}

__device__ __forceinline__ void xcd_barrier(const XcdBarrier& b) {
    asm volatile("s_waitcnt vmcnt(0)" ::: "memory");
    __syncthreads();
    if (threadIdx.x == 0) {
        unsigned* bar = b.bar;
        __builtin_amdgcn_s_waitcnt(0);
        unsigned nloc = b.st[0], nx = b.st[1];
        if (nloc == 0u) { xcd_barrier_complete(bar, b.x, nloc, nx, b.expect); b.st[0] = nloc; b.st[1] = nx; }
        const unsigned old = xb_add(&bar[XB_XSUB(b.x)], 1u);
        const unsigned gen = old / nloc;
        if (old + 1u == (gen + 1u) * nloc) {
            __builtin_amdgcn_fence(__ATOMIC_RELEASE, "agent");
            asm volatile("s_waitcnt vmcnt(0)" ::: "memory");
            const unsigned og = xb_add(&bar[XB_TOP], 1u);
            const unsigned tg = og / nx;
            if (og + 1u == (tg + 1u) * nx) xb_add(&bar[XB_TOPGEN], 1u);
            else XB_SPIN(xb_ld(&bar[XB_TOPGEN]) == tg, bar);
            __builtin_amdgcn_fence(__ATOMIC_ACQUIRE, "agent");
            xb_add(&bar[XB_XGEN(b.x)], 1u);
            asm volatile("s_waitcnt vmcnt(0)" ::: "memory");
        } else {
            XB_SPIN(xb_ld(&bar[XB_XGEN(b.x)]) == gen, bar);
            __builtin_amdgcn_fence(__ATOMIC_ACQUIRE, "agent");
            asm volatile("s_waitcnt vmcnt(0)" ::: "memory");
        }
    }
    __syncthreads();
}

struct Args {
    const float* x; const float* norm1_g; const float* w_in; const float* lru_conv_w; const float* lru_conv_b; const float* lru_w_a; const float* lru_b_a;
    const float* lru_w_x; const float* lru_b_x; const float* lru_lambda; const float* sc_conv_w; const float* lru_out_g; const float* sc_out_g; const float* w_out;
    const float* norm2_g; const float* mlp_w_up; const float* mlp_w_gate; const float* mlp_conv_w; const float* mlp_conv_b; const float* mlp_w_down; const float* final_g;
    float* out; unsigned char* ws; int ph_lo, ph_hi;
};
__device__ __forceinline__ float wave_sum(float v) {
#pragma unroll
    for (int o = 1; o < 64; o <<= 1) v += __shfl_xor(v, o);
    return v;
}
__device__ __forceinline__ float bf2f(unsigned short b) { return __builtin_bit_cast(float, (unsigned)b << 16); }
__device__ __forceinline__ float bflo(unsigned w) { return __builtin_bit_cast(float, w << 16); }
__device__ __forceinline__ float bfhi(unsigned w) { return __builtin_bit_cast(float, w & 0xffff0000u); }
__device__ __forceinline__ void unpack8(v4u w, float (&f)[8]) { f[0] = bflo(w.x); f[1] = bfhi(w.x); f[2] = bflo(w.y); f[3] = bfhi(w.y); f[4] = bflo(w.z); f[5] = bfhi(w.z); f[6] = bflo(w.w); f[7] = bfhi(w.w); }
__device__ __forceinline__ v4u pack8(const float (&f)[8]) { v4u w; w.x = pg8::cvt_pk_bf16(f[0], f[1]); w.y = pg8::cvt_pk_bf16(f[2], f[3]); w.z = pg8::cvt_pk_bf16(f[4], f[5]); w.w = pg8::cvt_pk_bf16(f[6], f[7]); return w; }

__device__ __forceinline__ void p0_tile_load(const float* W, int N, int k0, int n0, const float* gain, LAS float* scr, int lane) {
    const int kq = lane >> 3, n4 = (lane & 7) * 4;
    f32x4 v[8];
#pragma unroll
    for (int i = 0; i < 8; ++i) v[i] = *(const GAS f32x4*)(W + (size_t)(k0 + kq + 8 * i) * N + n0 + n4);
#pragma unroll
    for (int i = 0; i < 8; ++i) { const int kk = kq + 8 * i; const float g = gain ? gain[k0 + kk] : 1.0f; LAS float* d = scr + kk * 33 + n4; d[0] = v[i].x * g; d[1] = v[i].y * g; d[2] = v[i].z * g; d[3] = v[i].w * g; }
    LDS_WAIT(); asm volatile("" ::: "memory");
}
__device__ __forceinline__ void p0_tile_store(bf16* WT, int K, int k0, int rbase, LAS float* scr, int lane) {
    const int c = lane & 7;
#pragma unroll
    for (int j = 0; j < 4; ++j) { const int n = (lane >> 3) + 8 * j; const LAS float* s = scr + (8 * c) * 33 + n;
        v4u o; o.x = pk2(s[0 * 33], s[1 * 33]); o.y = pk2(s[2 * 33], s[3 * 33]); o.z = pk2(s[4 * 33], s[5 * 33]); o.w = pk2(s[6 * 33], s[7 * 33]);
        *(GAS v4u*)(WT + (size_t)(rbase + n) * K + k0 + 8 * c) = o; }
    LDS_WAIT(); asm volatile("" ::: "memory");
}
__device__ __forceinline__ void p0_transpose_item(const float* W, int K, int N, bf16* WT, int row_off, const float* gain, LAS float* scr, int item, int lane) {
    const int nblk = N / 32, kb = item / nblk, nb = item % nblk, k0 = 64 * kb, n0 = 32 * nb;
    p0_tile_load(W, N, k0, n0, gain, scr, lane); p0_tile_store(WT, K, k0, row_off + n0, scr, lane);
}
__device__ __forceinline__ void p0_transpose_item_ug(const float* W, bf16* WT, int half, const float* gain, LAS float* scr, int item, int lane) {
    constexpr int K = D, N = FF;
    const int nblk = N / 32, kb = item / nblk, nb = item % nblk, k0 = 64 * kb, n0 = 32 * nb;
    p0_tile_load(W, N, k0, n0, gain, scr, lane); p0_tile_store(WT, K, k0, 256 * (n0 / 128) + (n0 % 128) + 128 * half, scr, lane);
}

__global__ void __launch_bounds__(NWAVES * 64, 2) mk_fwd(Args args) {
    extern __shared__ __attribute__((aligned(16))) unsigned char lds_raw[];
    LAS unsigned char* lds = (LAS unsigned char*)lds_raw;
    volatile LAS unsigned* MISC = (volatile LAS unsigned*)(lds + MISC_OFF);
    const int tid_k = threadIdx.x, lane_k = tid_k & 63, wave = __builtin_amdgcn_readfirstlane(tid_k >> 6);
    const int bx = blockIdx.x, half = bx & (NG - 1), xg_ = (bx & 7) / NG;
    const int G = gridDim.x / NG;
    const int chh = (bx >> 3) * GX + xg_;
    const int vcu = xg_ * (G / GX) + (bx >> 3);
    const int gw = vcu * NWAVES + wave, NGW = G * NWAVES;
    unsigned char* ws = args.ws;
    for (int u = tid_k; u < (LDS_BYTES - XCH_OFF) / 4; u += NWAVES * 64) ((LAS unsigned*)(lds + XCH_OFF))[u] = 0u;
    __syncthreads();
    XcdBarrier bar = xcd_barrier_post((unsigned*)(ws + WS_CTL) + CW_BAR + half * XCD_BAR_WORDS, MISC + 8, (unsigned)G);
    unsigned* xflag = (unsigned*)(ws + WS_CTL) + CW_FLAG;
    bf16* Wa_t = (bf16*)(ws + WS_WA); bf16* Wx_t = (bf16*)(ws + WS_WX);
    float* ssq1 = (float*)(ws + WS_SSQ1) + (size_t)half * MH * 16; float* ssq2 = (float*)(ws + WS_SSQ2) + (size_t)half * MH * 16;
    float* Eh = (float*)(ws + WS_EH) + (size_t)half * BH * NCH * LW; float* EP = (float*)(ws + WS_EP) + (size_t)half * BH * NCH * LW; float* fixb = (float*)(ws + WS_FIX) + (size_t)half * (MH / 256) * 6 * FF;
    bf16* Win_t = (bf16*)(ws + WS_WIN); bf16* Wout_t = (bf16*)(ws + WS_WOUT); bf16* Wug_t = (bf16*)(ws + WS_WUG); bf16* Wdn_t = (bf16*)(ws + WS_WDN);
    unsigned char* rh = ws + WS_R + (size_t)half * R_HALF;
    bf16* hb = (bf16*)(ws + WS_HB) + (size_t)half * MH * D; bf16* yb = (bf16*)(ws + WS_Y) + (size_t)half * MH * D; bf16* proj = (bf16*)rh; bf16* act = (bf16*)rh;
    bf16* hloc = (bf16*)(rh + R_HLOC); bf16* pcum = (bf16*)(rh + R_PCUM);
    const float* xin = args.x + (size_t)half * MH * D; float* outp = args.out + (size_t)half * MH * D;
    const int lo = args.ph_lo, hi = args.ph_hi;
    int ph = 0;
#define RUN(k) (lo <= (k) && (k) < hi)
#define SEAM(k) do { if (RUN(k) && RUN((k) + 1)) xcd_barrier(bar); } while (0)

    if (RUN(ph)) REP(1) {
        int lane; asm volatile("v_mbcnt_lo_u32_b32 %0, -1, 0\n\tv_mbcnt_hi_u32_b32 %0, -1, %0" : "=v"(lane));
        LAS float* scr = (LAS float*)(lds + wave * 16384);
        constexpr int I_IN = (D / 64) * (INC / 32), I_OUT = (D / 64) * (D / 32), I_UP = (D / 64) * (FF / 32), I_DN = (FF / 64) * (D / 32), I_G = 2;
        constexpr int PER_LAYER = I_IN + I_OUT + 2 * I_UP + I_DN;
        const int TB0 = 0, TB1 = PER_LAYER, TB2 = PER_LAYER + (DEPTH - 1) * PER_LAYER * 5 / 18, TB3 = PER_LAYER + (DEPTH - 1) * PER_LAYER * 11 / 18, TB4 = DEPTH * PER_LAYER;
        const int tlo = half == 0 ? TB0 : half == 1 ? TB1 : half == 2 ? TB2 : TB3, thi = half == 0 ? TB1 : half == 1 ? TB2 : half == 2 ? TB3 : TB4;
        const int nmine = (thi - tlo) + (half == 0 ? DEPTH * 8 * 2 * I_G : 0);
        for (int it = gw; it < nmine; it += NGW) {
            int l, r;
            if (it >= thi - tlo) { r = it - (thi - tlo); l = r / (8 * 2 * I_G); r %= 8 * 2 * I_G;
                const int hd = r / (2 * I_G), mat = (r / I_G) & 1, sub = r % I_G; const size_t o = ((size_t)l * 8 + hd) * 64 * 64;
                p0_transpose_item((mat ? args.lru_w_x : args.lru_w_a) + o, 64, 64, (mat ? Wx_t : Wa_t) + o, 0, nullptr, scr, sub, lane); continue; }
            l = (it + tlo) / PER_LAYER; r = (it + tlo) % PER_LAYER;
            if (r < I_IN) { const int kb = r / (INC / 32), n0 = 32 * (r % (INC / 32));
                int rb = n0; if (n0 >= 2048) { const int f = n0 - 2048; rb = 1536 + 256 * (f / 128) + 128 + (f % 128); } else if (n0 >= 1536) { const int f = n0 - 1536; rb = 1536 + 256 * (f / 128) + (f % 128); }
                p0_tile_load(args.w_in + (size_t)l * D * INC, INC, 64 * kb, n0, args.norm1_g + l * D, scr, lane); p0_tile_store(Win_t + (size_t)l * INC * D, D, 64 * kb, rb, scr, lane); continue; } r -= I_IN;
            if (r < I_OUT) { const int kb = r / (D / 32); const float* g = (kb < 8) ? args.lru_out_g + l * LW + 0 : args.sc_out_g + l * LW - LW;
                p0_transpose_item(args.w_out + (size_t)l * D * D, D, D, Wout_t + (size_t)l * D * D, 0, g, scr, r, lane); continue; } r -= I_OUT;
            if (r < I_UP) { p0_transpose_item_ug(args.mlp_w_up + (size_t)l * D * FF, Wug_t + (size_t)l * 2 * FF * D, 0, args.norm2_g + l * D, scr, r, lane); continue; } r -= I_UP;
            if (r < I_UP) { p0_transpose_item_ug(args.mlp_w_gate + (size_t)l * D * FF, Wug_t + (size_t)l * 2 * FF * D, 1, args.norm2_g + l * D, scr, r, lane); continue; } r -= I_UP;
            p0_transpose_item(args.mlp_w_down + (size_t)l * FF * D, FF, D, Wdn_t + (size_t)l * D * FF, 0, nullptr, scr, r, lane);
        }
        for (int m = gw; m < MH; m += NGW) {
            const GAS f32x4* xr = (const GAS f32x4*)(xin + (size_t)m * D) + lane;
            f32x4 v[4]; float s = 0.f;
#pragma unroll
            for (int j = 0; j < 4; ++j) { v[j] = xr[64 * j]; s += (v[j].x * v[j].x + v[j].y * v[j].y) + (v[j].z * v[j].z + v[j].w * v[j].w); }
            s = wave_sum(s);
            GAS unsigned long long* o8 = (GAS unsigned long long*)(hb + (size_t)m * D) + lane;
#pragma unroll
            for (int j = 0; j < 4; ++j) o8[64 * j] = (unsigned long long)pg8::cvt_pk_bf16(v[j].x, v[j].y) | ((unsigned long long)pg8::cvt_pk_bf16(v[j].z, v[j].w) << 32);
            if (lane < 4) *(f32x4*)(ssq1 + (size_t)m * 16 + 4 * lane) = (f32x4){lane == 0 ? s : 0.f, 0.f, 0.f, 0.f};
        }
    }
    if (hi < 0) cooperative_groups::this_grid().sync();
    xcd_barrier(bar);
    if (vcu == 0 && tid_k == 0) __hip_atomic_store(xflag + 64 * half, 1u, __ATOMIC_RELEASE, __HIP_MEMORY_SCOPE_AGENT);
#define WAIT_HALF(h) do { if (tid_k == 0) { unsigned sp_ = 0; while (__hip_atomic_load(xflag + 64 * (h), __ATOMIC_RELAXED, __HIP_MEMORY_SCOPE_AGENT) == 0u && ++sp_ < (1u << 22)) __builtin_amdgcn_s_sleep(8); \
        __builtin_amdgcn_fence(__ATOMIC_ACQUIRE, "agent"); asm volatile("s_waitcnt vmcnt(0)" ::: "memory"); } __syncthreads(); } while (0)
    if (half != 0) WAIT_HALF(0);
    ++ph;

    for (int l = 0; l < DEPTH; ++l) {
        if (RUN(ph)) {
            if (l == 1) { for (int h2 = 1; h2 < NG; ++h2) if (h2 != half) WAIT_HALF(h2); }
            pg8::Gemm g{hb, Win_t + (size_t)l * INC * D, MH, INC, D}; pg8::StaticOrder S; S.init(MH, INC, G, chh, GX);
            pg8::EpiProj E{proj, PW, ssq1, 6, (LAS float*)(lds + XCH_OFF)};
            REP(2) pg8::gemm_phase<pg8::EpiProj, pg8::StaticOrder, true, true>(lds, g, S, E);
            if (tid_k == 0) *(volatile LAS int*)(lds + XCH_OFF + 1536 * 4) = 0;
        }
        SEAM(ph); ++ph;
        if (RUN(ph)) {
            int lane; asm volatile("v_mbcnt_lo_u32_b32 %0, -1, 0\n\tv_mbcnt_hi_u32_b32 %0, -1, %0" : "=v"(lane));
            const int fr = lane & 15, fq = lane >> 4, ch = 64 * wave + lane;
            LAS bf16* sA = (LAS bf16*)(lds + wave * 12288);
            LAS float* sR = (LAS float*)(lds + wave * 12288 + 2560);
            LAS float* sI = sR + 16 * 68;
            const float cw0 = args.lru_conv_w[(l * 4 + 0) * LW + ch], cw1 = args.lru_conv_w[(l * 4 + 1) * LW + ch], cw2 = args.lru_conv_w[(l * 4 + 2) * LW + ch], cw3 = args.lru_conv_w[(l * 4 + 3) * LW + ch];
            const float cbias = args.lru_conv_b[l * LW + ch], ba = args.lru_b_a[l * LW + ch], bx = args.lru_b_x[l * LW + ch];
            const float c2 = -8.0f * log1pf(__expf(-args.lru_lambda[l * LW + ch])) * 1.44269504089f;
            pg8::bf16x8 Ba[4][2], Bx[4][2];
#pragma unroll
            for (int nt = 0; nt < 4; ++nt)
#pragma unroll
                for (int ks = 0; ks < 2; ++ks) { const size_t o = (((size_t)l * 8 + wave) * 64 + 16 * nt + fr) * 64 + 32 * ks + 8 * fq;
                    Ba[nt][ks] = *(const pg8::bf16x8*)(Wa_t + o); Bx[nt][ks] = *(const pg8::bf16x8*)(Wx_t + o); }
            REP(4) for (int item = vcu; item < BH * NCH; item += G) {
                const int b = item % BH, c = item / BH;
                const size_t t0 = (size_t)b * SEQ + (size_t)c * CH;
                float xm3 = 0.f, xm2 = 0.f, xm1 = 0.f;
                if (c > 0) { xm3 = bf2f(proj[(t0 - 3) * PW + ch]); xm2 = bf2f(proj[(t0 - 2) * PW + ch]); xm1 = bf2f(proj[(t0 - 1) * PW + ch]); }
                float h = 0.f, P = 1.f;
                unsigned short xr[16];
#pragma unroll
                for (int j = 0; j < 16; ++j) xr[j] = proj[(t0 + j) * PW + ch];
#pragma unroll 1
                for (int g = 0; g < CH / 16; ++g) {
                    const size_t tg = t0 + 16 * g;
                    float xa[16];
#pragma unroll
                    for (int j = 0; j < 16; ++j) { const float xv = bf2f(xr[j]); xa[j] = cw0 * xm3 + cw1 * xm2 + cw2 * xm1 + cw3 * xv + cbias; xm3 = xm2; xm2 = xm1; xm1 = xv; }
                    { const size_t tn = (g + 1 < CH / 16) ? tg + 16 : tg;
#pragma unroll
                      for (int j = 0; j < 16; ++j) xr[j] = proj[(tn + j) * PW + ch]; }
#pragma unroll
                    for (int j = 0; j < 16; ++j) sA[j * 72 + lane] = (bf16)f2bf(xa[j]);
                    LDS_WAIT(); asm volatile("" ::: "memory");
                    const pg8::bf16x8 a0 = *(const LAS pg8::bf16x8*)(sA + fr * 72 + 8 * fq), a1 = *(const LAS pg8::bf16x8*)(sA + fr * 72 + 32 + 8 * fq);
                    f32x4 racc[4], iacc[4];
#pragma unroll
                    for (int nt = 0; nt < 4; ++nt) { racc[nt] = (f32x4){0.f, 0.f, 0.f, 0.f}; iacc[nt] = racc[nt];
                        racc[nt] = __builtin_amdgcn_mfma_f32_16x16x32_bf16(a0, Ba[nt][0], racc[nt], 0, 0, 0); racc[nt] = __builtin_amdgcn_mfma_f32_16x16x32_bf16(a1, Ba[nt][1], racc[nt], 0, 0, 0);
                        iacc[nt] = __builtin_amdgcn_mfma_f32_16x16x32_bf16(a0, Bx[nt][0], iacc[nt], 0, 0, 0); iacc[nt] = __builtin_amdgcn_mfma_f32_16x16x32_bf16(a1, Bx[nt][1], iacc[nt], 0, 0, 0); }
#pragma unroll
                    for (int nt = 0; nt < 4; ++nt)
#pragma unroll
                        for (int j = 0; j < 4; ++j) { sR[(4 * fq + j) * 68 + 16 * nt + fr] = racc[nt][j]; sI[(4 * fq + j) * 68 + 16 * nt + fr] = iacc[nt][j]; }
                    LDS_WAIT(); asm volatile("" ::: "memory");
                    {
                        typedef float f32x2v __attribute__((ext_vector_type(2)));
                        const float nk = -1.44269504089f;
                        bf16* hrow = hloc + tg * LW; bf16* prow = pcum + tg * LW;
#pragma unroll
                        for (int t = 0; t < 16; t += 2) {
                            const f32x2v sr = (f32x2v){sR[t * 68 + lane], sR[(t + 1) * 68 + lane]}, si = (f32x2v){sI[t * 68 + lane], sI[(t + 1) * 68 + lane]};
                            const f32x2v z1 = sr * nk + (nk * ba), z2 = si * nk + (nk * bx);
                            f32x2v e1, e2; e1.x = __builtin_amdgcn_exp2f(z1.x); e1.y = __builtin_amdgcn_exp2f(z1.y); e2.x = __builtin_amdgcn_exp2f(z2.x); e2.y = __builtin_amdgcn_exp2f(z2.y);
                            e1 = e1 + 1.0f; e2 = e2 + 1.0f;
                            f32x2v r, ig; r.x = __builtin_amdgcn_rcpf(e1.x); r.y = __builtin_amdgcn_rcpf(e1.y); ig.x = __builtin_amdgcn_rcpf(e2.x); ig.y = __builtin_amdgcn_rcpf(e2.y);
                            const f32x2v la = r * c2; f32x2v a; a.x = __builtin_amdgcn_exp2f(la.x); a.y = __builtin_amdgcn_exp2f(la.y);
                            const f32x2v m2 = 1.0f - a * a;
                            f32x2v mult; mult.x = __builtin_amdgcn_sqrtf(m2.x); mult.y = __builtin_amdgcn_sqrtf(m2.y);
                            const f32x2v bb = (mult * ig) * (f32x2v){xa[t], xa[t + 1]};
                            h = a.x * h + bb.x; P *= a.x;
                            { const unsigned w = pg8::cvt_pk_bf16(h, P); hrow[t * LW + ch] = (bf16)w; prow[t * LW + ch] = (bf16)(w >> 16); }
                            h = a.y * h + bb.y; P *= a.y;
                            { const unsigned w = pg8::cvt_pk_bf16(h, P); hrow[(t + 1) * LW + ch] = (bf16)w; prow[(t + 1) * LW + ch] = (bf16)(w >> 16); }
                        }
                    }
                    LDS_WAIT(); asm volatile("" ::: "memory");
                }
                Eh[((size_t)b * NCH + c) * LW + ch] = h; EP[((size_t)b * NCH + c) * LW + ch] = P;
            }
        }
        SEAM(ph); ++ph;
        if (RUN(ph)) {
            int lane; asm volatile("v_mbcnt_lo_u32_b32 %0, -1, 0\n\tv_mbcnt_hi_u32_b32 %0, -1, %0" : "=v"(lane));
            LAS float* sH = (LAS float*)lds;
            LAS float* sW = sH + 512;
            for (int i = wave * 64 + lane; i < 3 * LW; i += NWAVES * 64) sW[i] = args.sc_conv_w[l * 3 * LW + i];
            __syncthreads();
            REP(8) for (int item = vcu; item < BH * NCH; item += G) {
                const int b = item % BH, c = item / BH;
                {
                    const int ch = 64 * wave + lane; const float* ep = EP + (size_t)b * NCH * LW + ch; const float* eh = Eh + (size_t)b * NCH * LW + ch;
                    float pj[NCH], hj[NCH];
#pragma unroll
                    for (int j = 0; j < NCH - 1; ++j) { pj[j] = 1.f; hj[j] = 0.f; if (j < c) { pj[j] = ep[j * LW]; hj[j] = eh[j * LW]; } }
                    float Hc = 0.f;
#pragma unroll
                    for (int j = 0; j < NCH - 1; ++j) Hc = pj[j] * Hc + hj[j];
                    sH[ch] = Hc;
                }
                __syncthreads();
                float H[8];
                { const f32x4 ha = *(const LAS f32x4*)(sH + 8 * lane), hb4 = *(const LAS f32x4*)(sH + 8 * lane + 4);
#pragma unroll
                  for (int e = 0; e < 4; ++e) { H[e] = ha[e]; H[4 + e] = hb4[e]; } }
                const int s0 = c * CH + 8 * wave;
                const size_t t0 = (size_t)b * SEQ + s0;
                float cv1[8], cv2[8];
#pragma unroll
                for (int e = 0; e < 8; ++e) { cv1[e] = 0.f; cv2[e] = 0.f; }
                if (s0 > 0) { unpack8(*(const v4u*)(proj + (t0 - 1) * PW + 1536 + 8 * lane), cv1); unpack8(*(const v4u*)(proj + (t0 - 2) * PW + 1536 + 8 * lane), cv2); }
#pragma unroll 1
                for (int hf = 0; hf < 2; ++hf) {
                    v4u raw[4][5];
#pragma unroll
                    for (int tt = 0; tt < 4; ++tt) { const size_t t = t0 + 4 * hf + tt;
                        raw[tt][0] = *(const v4u*)(hloc + t * LW + 8 * lane); raw[tt][1] = *(const v4u*)(pcum + t * LW + 8 * lane);
                        raw[tt][2] = *(const v4u*)(proj + t * PW + 512 + 8 * lane); raw[tt][3] = *(const v4u*)(proj + t * PW + 1024 + 8 * lane);
                        raw[tt][4] = *(const v4u*)(proj + t * PW + 1536 + 8 * lane); }
#pragma unroll
                    for (int tt = 0; tt < 4; ++tt) { const size_t t = t0 + 4 * hf + tt;
                        float hl[8], pc[8], gt[8], sb[8], cvn[8], ya[8], yv[8];
                        unpack8(raw[tt][0], hl); unpack8(raw[tt][1], pc); unpack8(raw[tt][2], gt); unpack8(raw[tt][3], sb); unpack8(raw[tt][4], cvn);
                        float sa = 0.f, sbq = 0.f, w0[8], w1[8], w2[8];
                        { const f32x4 a0 = *(const LAS f32x4*)(sW + 8 * lane), a1 = *(const LAS f32x4*)(sW + 8 * lane + 4), b0 = *(const LAS f32x4*)(sW + LW + 8 * lane), b1 = *(const LAS f32x4*)(sW + LW + 8 * lane + 4),
                                      c0 = *(const LAS f32x4*)(sW + 2 * LW + 8 * lane), c1 = *(const LAS f32x4*)(sW + 2 * LW + 8 * lane + 4);
#pragma unroll
                          for (int e = 0; e < 4; ++e) { w0[e] = a0[e]; w0[4 + e] = a1[e]; w1[e] = b0[e]; w1[4 + e] = b1[e]; w2[e] = c0[e]; w2[4 + e] = c1[e]; } }
#pragma unroll
                        for (int e = 0; e < 8; ++e) { const float hh = hl[e] + pc[e] * H[e]; ya[e] = hh * pg8::gelu_tanh(gt[e]); sa += ya[e] * ya[e];
                            const float cv = cvn[e]; yv[e] = sb[e] * (w0[e] * cv2[e] + w1[e] * cv1[e] + w2[e] * cv); sbq += yv[e] * yv[e]; cv2[e] = cv1[e]; cv1[e] = cv; }
                        sa = wave_sum(sa); sbq = wave_sum(sbq);
                        const float ra = __builtin_amdgcn_rsqf(sa * (1.0f / LW) + pg8::RMS_EPS), rb = __builtin_amdgcn_rsqf(sbq * (1.0f / LW) + pg8::RMS_EPS);
#pragma unroll
                        for (int e = 0; e < 8; ++e) { ya[e] *= ra; yv[e] *= rb; }
                        *(v4u*)(yb + t * D + 8 * lane) = pack8(ya); *(v4u*)(yb + t * D + LW + 8 * lane) = pack8(yv);
                        __builtin_amdgcn_sched_barrier(0);
                    }
                }
                __syncthreads();
            }
        }
        SEAM(ph); ++ph;
        if (RUN(ph)) {
            pg8::Gemm g{yb, Wout_t + (size_t)l * D * D, MH, D, D}; pg8::StaticOrder S; S.init(MH, D, G, chh, GX);
            pg8::EpiRes E{hb, ssq2};
            pg8::gemm_phase<pg8::EpiRes, pg8::StaticOrder, true, true>(lds, g, S, E);
        }
        SEAM(ph); ++ph;
        if (RUN(ph)) {
            pg8::Gemm g{hb, Wug_t + (size_t)l * 2 * FF * D, MH, 2 * FF, D}; pg8::StaticOrder S; S.init(MH, 2 * FF, G, chh, GX);
            pg8::EpiUG E{act, ssq2, args.mlp_conv_w + (size_t)l * 3 * FF, args.mlp_conv_b + (size_t)l * FF, fixb, (LAS float*)(lds + XCH_OFF)};
#if PROBE_DUP & 64
            { pg8::EpiProj E2{act, FF, ssq2, 1000, (LAS float*)(lds + XCH_OFF)}; pg8::gemm_phase<pg8::EpiProj, pg8::StaticOrder, true, true>(lds, g, S, E2); }
#endif
            REP(16) pg8::gemm_phase<pg8::EpiUG, pg8::StaticOrder, true, true>(lds, g, S, E);
            if (tid_k == 0) *(volatile LAS int*)(lds + XCH_OFF + 1536 * 4) = 0;
        }
        SEAM(ph); ++ph;
        if (RUN(ph)) {
            pg8::Gemm g{act, Wdn_t + (size_t)l * D * FF, MH, D, FF}; pg8::StaticOrder S; S.init(MH, D, G, chh, GX);
            {
                const float* cw = args.mlp_conv_w + (size_t)l * 3 * FF; const float* cb = args.mlp_conv_b + (size_t)l * FF;
                int tid = tid_k; asm volatile("" : "+v"(tid));
                pg8::Unit uu;
                for (int ui = 0; S.next(ui, uu); ++ui) {
                    const int pm = uu.pm;
                    for (int i = tid; i < FF / 4; i += NWAVES * 64) {
                        const int f = 4 * i;
                        const float* fb = fixb + (size_t)pm * 6 * FF + f;
                        const f32x4 u0 = *(const f32x4*)(fb), u1 = *(const f32x4*)(fb + FF), g0 = *(const f32x4*)(fb + 2 * FF), g1 = *(const f32x4*)(fb + 3 * FF);
                        f32x4 pm2 = (f32x4){0.f, 0.f, 0.f, 0.f}, pm1 = pm2;
                        if (pm % (SEQ / 256) != 0) { pm2 = *(const f32x4*)(fb - 2 * FF); pm1 = *(const f32x4*)(fb - FF); }
                        const f32x4 w0 = *(const f32x4*)(cw + f), w1 = *(const f32x4*)(cw + FF + f), w2 = *(const f32x4*)(cw + 2 * FF + f), bb = *(const f32x4*)(cb + f);
                        float o0[4], o1[4];
#pragma unroll
                        for (int e = 0; e < 4; ++e) { o0[e] = pg8::gelu_tanh(w0[e] * pm2[e] + w1[e] * pm1[e] + w2[e] * u0[e] + bb[e]) * g0[e];
                                                      o1[e] = pg8::gelu_tanh(w0[e] * pm1[e] + w1[e] * u0[e] + w2[e] * u1[e] + bb[e]) * g1[e]; }
                        typedef unsigned u32x2v __attribute__((ext_vector_type(2)));
                        u32x2v a; a.x = pg8::cvt_pk_bf16(o0[0], o0[1]); a.y = pg8::cvt_pk_bf16(o0[2], o0[3]); *(u32x2v*)(act + (size_t)(pm * 256) * FF + f) = a;
                        a.x = pg8::cvt_pk_bf16(o1[0], o1[1]); a.y = pg8::cvt_pk_bf16(o1[2], o1[3]); *(u32x2v*)(act + (size_t)(pm * 256 + 1) * FF + f) = a;
                    }
                }
                VM_WAIT(); __syncthreads();
            }
            pg8::EpiRes E{hb, ssq1};
            pg8::gemm_phase<pg8::EpiRes, pg8::StaticOrder, true, true>(lds, g, S, E);
        }
        SEAM(ph); ++ph;
    }
    if (RUN(ph)) {
        int lane; asm volatile("v_mbcnt_lo_u32_b32 %0, -1, 0\n\tv_mbcnt_hi_u32_b32 %0, -1, %0" : "=v"(lane));
        f32x4 gf[4];
#pragma unroll
        for (int j = 0; j < 4; ++j) gf[j] = *((const f32x4*)args.final_g + lane + 64 * j);
        for (int m = gw; m < MH; m += NGW) {
            const float pr = (lane < 16) ? ssq1[(size_t)m * 16 + lane] : 0.f;
            const float rs = __builtin_amdgcn_rsqf(wave_sum(pr) * (1.0f / D) + pg8::RMS_EPS);
            const GAS unsigned long long* hr = (const GAS unsigned long long*)(hb + (size_t)m * D) + lane;
            GAS f32x4* xr = (GAS f32x4*)(outp + (size_t)m * D) + lane;
#pragma unroll
            for (int j = 0; j < 4; ++j) { const unsigned long long q = hr[64 * j]; const unsigned qa = (unsigned)q, qb = (unsigned)(q >> 32);
                f32x4 v = (f32x4){bflo(qa), bfhi(qa), bflo(qb), bfhi(qb)}; v = v * rs * gf[j]; xr[64 * j] = v; }
        }
    }
#undef RUN
#undef SEAM
}
constexpr int N_PHASES = 2 + DEPTH * 6;
static_assert(MK_N_LAUNCHES == 1, "the two-half schedule is one cooperative launch");

extern "C" void kernel_launch(void* const* d_in, const int* in_sizes, int n_in, void* d_out, int out_size, void* d_ws, size_t ws_size, hipStream_t stream) {
    static int grid = 0;
    if (grid == 0) {
        if (n_in != 21 || in_sizes[0] != M * D || out_size != M * D || ws_size < WS_END) { fprintf(stderr, "kernel_launch: unexpected shapes (n_in %d, in0 %d, out %d, ws %zu); nothing launched\n", n_in, n_in > 0 ? in_sizes[0] : -1, out_size, ws_size); grid = -1; return; }
        int dev = 0, cus = 0, per_cu = 0;
        if (hipGetDevice(&dev) != hipSuccess || hipDeviceGetAttribute(&cus, hipDeviceAttributeMultiprocessorCount, dev) != hipSuccess) { grid = -1; return; }
        if (hipFuncSetAttribute((const void*)mk_fwd, hipFuncAttributeMaxDynamicSharedMemorySize, LDS_BYTES) != hipSuccess) { fprintf(stderr, "kernel_launch: hipFuncSetAttribute failed\n"); grid = -1; return; }
        if (hipOccupancyMaxActiveBlocksPerMultiprocessor(&per_cu, (const void*)mk_fwd, NWAVES * 64, LDS_BYTES) != hipSuccess || per_cu < 1) { fprintf(stderr, "kernel_launch: occupancy query says %d\n", per_cu); per_cu = 1; }
        (void)hipGetLastError();
        grid = cus;
        if (grid % 8 != 0 || grid < 64) { fprintf(stderr, "kernel_launch: the two-half schedule needs a multiple of 8 workgroups (got %d); nothing launched\n", grid); grid = -1; return; }
    }
    if (grid < 0) return;
    (void)hipMemsetAsync((char*)d_ws + WS_CTL, 0, CTL_ZERO_BYTES, stream);
    Args a{};
    const float** ap = (const float**)&a;
    for (int i = 0; i < 21; ++i) ap[i] = (const float*)d_in[i];
    a.out = (float*)d_out; a.ws = (unsigned char*)d_ws;
#if MK_N_LAUNCHES == 1
    a.ph_lo = 0; a.ph_hi = N_PHASES;
    void* kargs[] = {&a};
    hipError_t e = hipLaunchCooperativeKernel((const void*)mk_fwd, dim3(grid), dim3(NWAVES * 64), kargs, LDS_BYTES, stream);
    if (e != hipSuccess) fprintf(stderr, "kernel_launch: cooperative launch failed: %s (grid %d)\n", hipGetErrorString(e), grid);
#else
    for (int p = 0; p < N_PHASES; ++p) { a.ph_lo = p; a.ph_hi = p + 1; hipLaunchKernelGGL(mk_fwd, dim3(grid), dim3(NWAVES * 64), LDS_BYTES, stream, a); }
#endif
}
```

```cpp
#include <hip/hip_runtime.h>
#include <cstdio>
#include <cstdint>
namespace pg8 {
#define PG8_LAS __attribute__((address_space(3)))
typedef unsigned short bf16_t;
typedef short bf16x8 __attribute__((ext_vector_type(8)));
typedef float f32x4 __attribute__((ext_vector_type(4)));
typedef unsigned u32x4 __attribute__((ext_vector_type(4)));
constexpr int BM = 256, BK = 64, HALF = 128, HTB = HALF * BK * 2  , STAGE_BYTES = 8 * HTB, NXCD = 8, WGM = 8;

__host__ __device__ __forceinline__ int lds_byte(int r, int c) { const int st = (r >> 4) * 2 + (c >> 5), rr = r & 15, cc = c & 31, ob = rr * 64 + cc * 2; return st * 1024 + (ob ^ (((ob >> 9) & 1) << 5)); }
__host__ __device__ __forceinline__ void stage_rc(int b, int& R, int& C) { const int st = b / 1024, sb = b % 1024, swz = sb ^ (((sb >> 9) & 1) << 5); R = (st >> 1) * 16 + swz / 64; C = (st & 1) * 32 + (swz % 64) / 2; }
__host__ __device__ __forceinline__ int perm32(int rho) { const int n = rho >> 4, i = rho & 15; return 8 * (i >> 2) + 4 * n + (i & 3); }

struct Unit { int pm, pn; };
struct Gemm { const bf16_t* A; const bf16_t* Bt; int M, N, K; };

struct StaticOrder {
    int nM, nN, nwg, G, c, nx;
    __host__ __device__ void init(int M, int N, int G_, int c_, int nx_ = NXCD) { nM = M / BM; nN = N / BM; nwg = nM * nN; G = G_; c = c_; nx = nx_; }
    __host__ __device__ bool next(int i, Unit& u) const {
        const long L = (long)i * G + c; if (L >= nwg) return false;
        int wgid = (int)L; { const int q = nwg / nx, r = nwg % nx, xcd = wgid % nx, off = wgid / nx; wgid = (xcd < r ? xcd * (q + 1) : r * (q + 1) + (xcd - r) * q) + off; }
        const int nig = WGM * nN, gid = wgid / nig, fm = gid * WGM, gsz = (nM - fm) < WGM ? (nM - fm) : WGM;
        u.pm = fm + ((wgid % nig) % gsz); u.pn = (wgid % nig) / gsz; return true;
    }
    __device__ __forceinline__ void a_ready(const Unit&) const {}
    __device__ __forceinline__ void done(const Unit&) const {}
};

__device__ __forceinline__ unsigned cvt_pk_bf16(float lo, float hi) { unsigned r; asm volatile("v_cvt_pk_bf16_f32 %0, %1, %2" : "=v"(r) : "v"(lo), "v"(hi)); return r; }
typedef float f32x2 __attribute__((ext_vector_type(2)));
__device__ __forceinline__ f32x2 gelu_pk(f32x2 v) {
    const f32x2 av = __builtin_elementwise_abs(v), d = av * 0.2316418882f + 1.0f;
    f32x2 t; t.x = __builtin_amdgcn_rcpf(d.x); t.y = __builtin_amdgcn_rcpf(d.y);
    f32x2 q = t * 0.5307027145f + (-0.7265760135f); q = q * t + 0.7107068705f; q = q * t + (-0.142248368f); q = q * t + 0.127414796f; q = q * t;
    const f32x2 s = (v * v) * (-0.72134752044f);
    f32x2 e; e.x = __builtin_amdgcn_exp2f(s.x); e.y = __builtin_amdgcn_exp2f(s.y);
    const f32x2 m = v * (q * e), r = v - m;
    f32x2 o; o.x = v.x < 0.f ? m.x : r.x; o.y = v.y < 0.f ? m.y : r.y; return o;
}


constexpr float RMS_EPS = 1e-6f;
__device__ __forceinline__ float dpp_ror1(float v) { return __builtin_bit_cast(float, __builtin_amdgcn_update_dpp(0, __builtin_bit_cast(int, v), 0x121, 0xf, 0xf, false)); }
__device__ __forceinline__ float dpp_ror2(float v) { return __builtin_bit_cast(float, __builtin_amdgcn_update_dpp(0, __builtin_bit_cast(int, v), 0x122, 0xf, 0xf, false)); }
__device__ __forceinline__ float gelu_tanh(float x) {
    const float z = x * (1.0f + 0.044715f * x * x) * (-2.3022081985f);
    return x * __builtin_amdgcn_rcpf(1.0f + __builtin_amdgcn_exp2f(z));
}
__device__ __forceinline__ f32x2 gelu_tanh_pk(f32x2 v) {
    f32x2 t = v * v; t = t * (0.044715f * -2.3022081985f) + (-2.3022081985f);
    const f32x2 z = v * t; f32x2 e; e.x = __builtin_amdgcn_exp2f(z.x); e.y = __builtin_amdgcn_exp2f(z.y); e = e + 1.0f;
    f32x2 r; r.x = __builtin_amdgcn_rcpf(e.x); r.y = __builtin_amdgcn_rcpf(e.y); return v * r;
}
__device__ __forceinline__ void load_rs(const float* ssq, int r0, int fq, float (&rs)[2][4]) {
#pragma unroll
    for (int ai = 0; ai < 2; ++ai)
#pragma unroll
        for (int m = 0; m < 4; ++m) {
            const f32x4 p = *(const f32x4*)(ssq + (size_t)(r0 + ai * HALF + m * 16) * 16 + 4 * fq);
            float s = (p[0] + p[1]) + (p[2] + p[3]);
            s += __shfl_xor(s, 16); s += __shfl_xor(s, 32);
            rs[ai][m] = __builtin_amdgcn_rsqf(s * (1.0f / 1024.0f) + RMS_EPS);
        }
}
__device__ __forceinline__ bool get_rs(PG8_LAS float* xch, const float* ssq, int pm, int row0, int wr, int wc, int fr, int fq, float (&rs)[2][4]) {
    PG8_LAS float* rsbuf = xch + 1280; volatile PG8_LAS int* rstag = (volatile PG8_LAS int*)(xch + 1536);
    const bool miss = (rstag[0] != pm + 1);
    if (miss) { load_rs(ssq, row0, fq, rs);
        if (wc == 0 && fq == 0) {
#pragma unroll
            for (int ai = 0; ai < 2; ++ai)
#pragma unroll
                for (int m = 0; m < 4; ++m) rsbuf[ai * HALF + wr * 64 + m * 16 + fr] = rs[ai][m]; }
    } else {
#pragma unroll
        for (int ai = 0; ai < 2; ++ai)
#pragma unroll
            for (int m = 0; m < 4; ++m) rs[ai][m] = rsbuf[ai * HALF + wr * 64 + m * 16 + fr];
    }
    return miss;
}
struct EpiProj {
    static constexpr bool PERM = true, AFTER_DRAIN = false;
    bf16_t* O; int ldc; const float* ssq; int pn_prod; PG8_LAS float* xch;
    __device__ __forceinline__ void operator()(const f32x4 (&acc)[2][2][4][2], const Unit& u, int wr, int wc, int fr, int fq) const {
        const int row0 = u.pm * BM + wr * 64 + fr;
        float rs[2][4]; const bool miss = get_rs(xch, ssq, u.pm, row0, wr, wc, fr, fq, rs);
        if (u.pn < pn_prod) {
            const int col0 = u.pn * BM + wc * 32 + 8 * fq;
#pragma unroll
            for (int ai = 0; ai < 2; ++ai)
#pragma unroll
                for (int m = 0; m < 4; ++m) { bf16_t* rowp = O + (size_t)(row0 + ai * HALF + m * 16) * ldc + col0; const float s = rs[ai][m];
#pragma unroll
                    for (int bj = 0; bj < 2; ++bj) { const f32x4 v0 = acc[ai][bj][m][0] * s, v1 = acc[ai][bj][m][1] * s;
                        u32x4 w; w.x = cvt_pk_bf16(v0[0], v0[1]); w.y = cvt_pk_bf16(v0[2], v0[3]); w.z = cvt_pk_bf16(v1[0], v1[1]); w.w = cvt_pk_bf16(v1[2], v1[3]);
                        *(u32x4*)(rowp + bj * HALF) = w; } }
        } else {
            const int col0 = pn_prod * BM + (u.pn - pn_prod) * HALF + wc * 32 + 8 * fq;
#pragma unroll
            for (int ai = 0; ai < 2; ++ai)
#pragma unroll
                for (int m = 0; m < 4; ++m) { const float s2 = rs[ai][m] * rs[ai][m];
                    const f32x4 v0 = acc[ai][0][m][0] * acc[ai][1][m][0] * s2, v1 = acc[ai][0][m][1] * acc[ai][1][m][1] * s2;
                    u32x4 w; w.x = cvt_pk_bf16(v0[0], v0[1]); w.y = cvt_pk_bf16(v0[2], v0[3]); w.z = cvt_pk_bf16(v1[0], v1[1]); w.w = cvt_pk_bf16(v1[2], v1[3]);
                    *(u32x4*)(O + (size_t)(row0 + ai * HALF + m * 16) * ldc + col0) = w; }
        }
        if (miss) { asm volatile("s_waitcnt lgkmcnt(0)" ::: "memory"); __builtin_amdgcn_s_barrier(); asm volatile("" ::: "memory");
            if (wr == 0 && wc == 0 && fr == 0 && fq == 0) *(volatile PG8_LAS int*)(xch + 1536) = u.pm + 1; }
    }
};
struct EpiRes {
    static constexpr bool PERM = true, AFTER_DRAIN = false;
    bf16_t* hb; float* ssq_out;
    __device__ __forceinline__ void operator()(const f32x4 (&acc)[2][2][4][2], const Unit& u, int wr, int wc, int fr, int fq) const {
        const int row0 = u.pm * BM + wr * 64 + fr, col0 = u.pn * BM + wc * 32 + 8 * fq;
#pragma unroll
        for (int ai = 0; ai < 2; ++ai)
#pragma unroll
            for (int m = 0; m < 4; ++m) { const int r = row0 + ai * HALF + m * 16; bf16_t* rowp = hb + (size_t)r * 1024 + col0; float s = 0.f;
                u32x4 bq[2];
#pragma unroll
                for (int bj = 0; bj < 2; ++bj) bq[bj] = *(const u32x4*)(rowp + bj * HALF);
#pragma unroll
                for (int bj = 0; bj < 2; ++bj) { const u32x4 b = bq[bj]; const f32x4 a0 = acc[ai][bj][m][0], a1 = acc[ai][bj][m][1];
                    const float o0 = __builtin_bit_cast(float, b.x << 16) + a0[0], o1 = __builtin_bit_cast(float, b.x & 0xffff0000u) + a0[1], o2 = __builtin_bit_cast(float, b.y << 16) + a0[2], o3 = __builtin_bit_cast(float, b.y & 0xffff0000u) + a0[3];
                    const float o4 = __builtin_bit_cast(float, b.z << 16) + a1[0], o5 = __builtin_bit_cast(float, b.z & 0xffff0000u) + a1[1], o6 = __builtin_bit_cast(float, b.w << 16) + a1[2], o7 = __builtin_bit_cast(float, b.w & 0xffff0000u) + a1[3];
                    s += ((o0 * o0 + o1 * o1) + (o2 * o2 + o3 * o3)) + ((o4 * o4 + o5 * o5) + (o6 * o6 + o7 * o7));
                    u32x4 w; w.x = cvt_pk_bf16(o0, o1); w.y = cvt_pk_bf16(o2, o3); w.z = cvt_pk_bf16(o4, o5); w.w = cvt_pk_bf16(o6, o7);
                    *(u32x4*)(rowp + bj * HALF) = w; }
                s += __shfl_xor(s, 16); s += __shfl_xor(s, 32);
                if (fq == 0) ssq_out[(size_t)r * 16 + u.pn * 4 + wc] = s; }
    }
};
struct EpiUG {
    static constexpr bool PERM = true, AFTER_DRAIN = false;
    bf16_t* act; const float* ssq; const float* cw; const float* cb; float* fixb; PG8_LAS float* xch;
    __device__ __forceinline__ void operator()(f32x4 (&acc)[2][2][4][2], const Unit& u, int wr, int wc, int fr, int fq) const {
        const int row0 = u.pm * BM + wr * 64 + fr, lcol = wc * 32 + 8 * fq, fcol = u.pn * HALF + lcol;
        PG8_LAS float* wts = xch + 768;
        const int tid_e = (wr * 4 + wc) * 64 + fq * 16 + fr;
        const float wv = (tid_e < 384) ? cw[(tid_e >> 7) * 3072 + u.pn * HALF + (tid_e & 127)] : cb[u.pn * HALF + (tid_e & 127)];
        float rs[2][4]; const bool miss = get_rs(xch, ssq, u.pm, row0, wr, wc, fr, fq, rs);
#pragma unroll
        for (int ai = 0; ai < 2; ++ai)
#pragma unroll
            for (int m = 0; m < 4; ++m)
#pragma unroll
                for (int bj = 0; bj < 2; ++bj)
#pragma unroll
                    for (int n = 0; n < 2; ++n) acc[ai][bj][m][n] = acc[ai][bj][m][n] * rs[ai][m];
        if (fr >= 14) {
#pragma unroll
            for (int ai = 0; ai < 2; ++ai) { const int q = 2 * ai + wr;
                if (q < 3) {
#pragma unroll
                    for (int n = 0; n < 2; ++n) *(PG8_LAS f32x4*)(xch + (q * 2 + (fr - 14)) * HALF + lcol + 4 * n) = acc[ai][0][3][n];
                } else {
#pragma unroll
                    for (int n = 0; n < 2; ++n) *(f32x4*)(fixb + ((size_t)u.pm * 6 + 4 + (fr - 14)) * 3072 + fcol + 4 * n) = acc[ai][0][3][n];
                } }
        }
        if (wr == 0 && fr < 2) {
#pragma unroll
            for (int n = 0; n < 2; ++n) { *(f32x4*)(fixb + ((size_t)u.pm * 6 + fr) * 3072 + fcol + 4 * n) = acc[0][0][0][n];
                                          *(f32x4*)(fixb + ((size_t)u.pm * 6 + 2 + fr) * 3072 + fcol + 4 * n) = acc[0][1][0][n]; }
        }
        wts[tid_e] = wv;
        asm volatile("s_waitcnt lgkmcnt(0)" ::: "memory"); __builtin_amdgcn_s_barrier(); asm volatile("" ::: "memory");
        if (miss && tid_e == 0) *(volatile PG8_LAS int*)(xch + 1536) = u.pm + 1;
        typedef unsigned u32x2v __attribute__((ext_vector_type(2)));
        u32x2v wlo[2][4];
#pragma unroll
        for (int n = 0; n < 2; ++n) {
            const f32x4 w0 = *(const PG8_LAS f32x4*)(wts + lcol + 4 * n), w1 = *(const PG8_LAS f32x4*)(wts + 128 + lcol + 4 * n), w2 = *(const PG8_LAS f32x4*)(wts + 256 + lcol + 4 * n), bb = *(const PG8_LAS f32x4*)(wts + 384 + lcol + 4 * n);
#pragma unroll
            for (int ai = 0; ai < 2; ++ai) { const int q = 2 * ai + wr;
                f32x4 B0 = (f32x4){0.f, 0.f, 0.f, 0.f}, B1 = B0;
                if (q > 0) { B0 = *(const PG8_LAS f32x4*)(xch + ((q - 1) * 2 + 0) * HALF + lcol + 4 * n); B1 = *(const PG8_LAS f32x4*)(xch + ((q - 1) * 2 + 1) * HALF + lcol + 4 * n); }
                f32x4 R1p = B1, R2p;
#pragma unroll
                for (int e = 0; e < 4; ++e) R2p[e] = (fr == 1) ? B1[e] : B0[e];
#pragma unroll
                for (int m = 0; m < 4; ++m) { const f32x4 cur = acc[ai][0][m][n], gt = acc[ai][1][m][n]; f32x4 R1, R2, p1, p2;
#pragma unroll
                    for (int e = 0; e < 4; ++e) { R1[e] = dpp_ror1(cur[e]); R2[e] = dpp_ror2(cur[e]); p1[e] = (fr >= 1) ? R1[e] : R1p[e]; p2[e] = (fr >= 2) ? R2[e] : R2p[e]; }
                    R1p = R1; R2p = R2;
                    const f32x2 va = (f32x2){w0[0], w0[1]} * (f32x2){p2[0], p2[1]} + (f32x2){w1[0], w1[1]} * (f32x2){p1[0], p1[1]} + (f32x2){w2[0], w2[1]} * (f32x2){cur[0], cur[1]} + (f32x2){bb[0], bb[1]};
                    const f32x2 vb = (f32x2){w0[2], w0[3]} * (f32x2){p2[2], p2[3]} + (f32x2){w1[2], w1[3]} * (f32x2){p1[2], p1[3]} + (f32x2){w2[2], w2[3]} * (f32x2){cur[2], cur[3]} + (f32x2){bb[2], bb[3]};
                    const f32x2 oa = gelu_tanh_pk(va) * (f32x2){gt[0], gt[1]}, ob = gelu_tanh_pk(vb) * (f32x2){gt[2], gt[3]};
                    u32x2v w; w.x = cvt_pk_bf16(oa.x, oa.y); w.y = cvt_pk_bf16(ob.x, ob.y);
                    if (n == 0) wlo[ai][m] = w;
                    else { u32x4 w4; w4.x = wlo[ai][m].x; w4.y = wlo[ai][m].y; w4.z = w.x; w4.w = w.y; *(u32x4*)(act + (size_t)(row0 + ai * HALF + m * 16) * 3072 + fcol) = w4; } } }
        }
    }
};

template <class Epi, class Sched, bool ALIGN_EPI = false, bool SP2 = false>
__device__ __forceinline__ void gemm_phase(PG8_LAS unsigned char* lds, const Gemm g, const Sched& S, const Epi& E) {
    int tid_o = threadIdx.x; asm volatile("" : "+v"(tid_o));
    const int tid = tid_o, wid = __builtin_amdgcn_readfirstlane(tid >> 6), lane = tid & 63, wr = wid >> 2, wc = wid & 3, fr = lane & 15, fq = lane >> 4;
    const int K = g.K, nt = K / BK;
    unsigned voffA[2], voffB[2];
#pragma unroll
    for (int i = 0; i < 2; ++i) { int R, C; stage_rc(tid * 16 + i * 8192, R, C); const int Rb = Epi::PERM ? ((R & ~31) + perm32(R & 31)) : R;
        voffA[i] = (unsigned)(R * K + C) * 2u; voffB[i] = (unsigned)(Rb * K + C) * 2u; }
    const size_t kstep = (size_t)(BK * 2);
    const size_t hstep = (size_t)HALF * K * 2;
    const size_t tstep = 2 * hstep;
    const unsigned ldsw = (unsigned)wid * 1024u;
    const int aoff = lds_byte(wr * 64 + fr, fq * 8), boff = lds_byte(wc * 32 + fr, fq * 8);
#define PG8_SA(b, h) (((b) * 2 + (h)) * HTB)
#define PG8_SB(b, h) ((4 + (b) * 2 + (h)) * HTB)
#define PG8_STAGE(bufoff, gbase, voff) do { _Pragma("unroll") for (int _i = 0; _i < 2; ++_i) \
        __builtin_amdgcn_global_load_lds((const unsigned*)((const char*)(gbase) + (voff)[_i]), (PG8_LAS unsigned*)(lds + (bufoff) + ldsw + _i * 8192), 16, 0, 0); } while (0)
#define PG8_LDA(dst, b, h) do { _Pragma("unroll") for (int m = 0; m < 4; ++m) _Pragma("unroll") for (int k = 0; k < 2; ++k) dst[m][k] = *(const PG8_LAS bf16x8*)(lds + PG8_SA(b, h) + aoff + m * 2048 + k * 1024); } while (0)
#define PG8_LDB(dst, b, h) do { _Pragma("unroll") for (int n = 0; n < 2; ++n) _Pragma("unroll") for (int k = 0; k < 2; ++k) dst[n][k] = *(const PG8_LAS bf16x8*)(lds + PG8_SB(b, h) + boff + n * 2048 + k * 1024); } while (0)
#define PG8_MMA(ai, bj, At, Bt) do { __builtin_amdgcn_s_setprio(1); _Pragma("unroll") for (int m = 0; m < 4; ++m) _Pragma("unroll") for (int n = 0; n < 2; ++n) _Pragma("unroll") for (int k = 0; k < 2; ++k) \
        acc[ai][bj][m][n] = __builtin_amdgcn_mfma_f32_16x16x32_bf16(Bt[n][k], At[m][k], acc[ai][bj][m][n], 0, 0, 0); __builtin_amdgcn_s_setprio(0); } while (0)
#define PG8_WAIT_V(n) asm volatile("s_waitcnt vmcnt(" #n ")" ::: "memory")
#define PG8_WAIT_L(n) asm volatile("s_waitcnt lgkmcnt(" #n ")" ::: "memory")
#define PG8_BAR __builtin_amdgcn_s_barrier()
#define PG8_SCHED __builtin_amdgcn_sched_barrier(0)
    Unit cur, nxt; int ui = 0;
    if (!S.next(0, cur)) return;
    f32x4 acc[2][2][4][2];
#pragma unroll
    for (int a = 0; a < 2; ++a)
#pragma unroll
        for (int b = 0; b < 2; ++b)
#pragma unroll
            for (int m = 0; m < 4; ++m)
#pragma unroll
                for (int n = 0; n < 2; ++n) acc[a][b][m][n] = (f32x4){0.f, 0.f, 0.f, 0.f};
    bf16x8 At[4][2], B0[2][2], B1[2][2];
    const char* cA = (const char*)g.A + (size_t)cur.pm * tstep; const char* cB = (const char*)g.Bt + (size_t)cur.pn * tstep;
    S.a_ready(cur);
    if constexpr (SP2) {
        PG8_STAGE(PG8_SB(0, 0), cB, voffB); PG8_STAGE(PG8_SB(0, 1), cB + hstep, voffB); PG8_STAGE(PG8_SA(0, 0), cA, voffA); PG8_STAGE(PG8_SA(0, 1), cA + hstep, voffA);
        if (wr == 1) PG8_BAR;
        PG8_WAIT_V(2); PG8_BAR;
        PG8_STAGE(PG8_SB(1, 0), cB + kstep, voffB); PG8_STAGE(PG8_SA(1, 0), cA + kstep, voffA); PG8_STAGE(PG8_SB(1, 1), cB + hstep + kstep, voffB);
        PG8_WAIT_V(6); PG8_BAR;
    } else {
        PG8_STAGE(PG8_SB(0, 0), cB, voffB); PG8_STAGE(PG8_SA(0, 0), cA, voffA); PG8_STAGE(PG8_SB(0, 1), cB + hstep, voffB); PG8_STAGE(PG8_SA(0, 1), cA + hstep, voffA);
        if (wr == 1) PG8_BAR;
        PG8_WAIT_V(4); PG8_BAR;
        PG8_STAGE(PG8_SB(1, 0), cB + kstep, voffB); PG8_STAGE(PG8_SA(1, 0), cA + kstep, voffA); PG8_STAGE(PG8_SB(1, 1), cB + hstep + kstep, voffB);
        PG8_WAIT_V(6); PG8_BAR;
    }
    for (;;) {
        const bool has_next = S.next(ui + 1, nxt);
        const char* nA = has_next ? (const char*)g.A + (size_t)nxt.pm * tstep : cA; const char* nB = has_next ? (const char*)g.Bt + (size_t)nxt.pn * tstep : cB;
        for (int t = 0; t < nt; t += 2) {
            const bool last = (t == nt - 2);
            const char* a1 = cA + (size_t)(t + 1) * kstep;
            const char* a2 = last ? nA : cA + (size_t)(t + 2) * kstep; const char* b2 = last ? nB : cB + (size_t)(t + 2) * kstep;
            const char* a3 = a2 + kstep; const char* b3 = b2 + kstep;
            if (last && has_next) S.a_ready(nxt);
            if constexpr (SP2) {
            PG8_LDB(B0, 0, 0); PG8_LDB(B1, 0, 1); PG8_SCHED; PG8_LDA(At, 0, 0); PG8_STAGE(PG8_SA(1, 1), a1 + hstep, voffA);
            PG8_WAIT_V(8); PG8_WAIT_L(0); PG8_BAR; PG8_MMA(0, 0, At, B0); PG8_MMA(0, 1, At, B1); PG8_BAR; PG8_SCHED;
            PG8_LDA(At, 0, 1); PG8_STAGE(PG8_SB(0, 0), b2, voffB); PG8_STAGE(PG8_SB(0, 1), b2 + hstep, voffB); PG8_STAGE(PG8_SA(0, 0), a2, voffA);
            PG8_WAIT_V(8); PG8_WAIT_L(0); PG8_BAR; PG8_MMA(1, 0, At, B0); PG8_MMA(1, 1, At, B1); PG8_BAR; PG8_SCHED;
            PG8_LDB(B0, 1, 0); PG8_LDB(B1, 1, 1); PG8_SCHED; PG8_LDA(At, 1, 0); PG8_STAGE(PG8_SA(0, 1), a2 + hstep, voffA);
            PG8_WAIT_V(8); PG8_WAIT_L(0); PG8_BAR; PG8_MMA(0, 0, At, B0); PG8_MMA(0, 1, At, B1); PG8_BAR; PG8_SCHED;
            PG8_LDA(At, 1, 1); PG8_STAGE(PG8_SB(1, 0), b3, voffB); PG8_STAGE(PG8_SB(1, 1), b3 + hstep, voffB); PG8_STAGE(PG8_SA(1, 0), a3, voffA);
            PG8_WAIT_V(8); PG8_WAIT_L(0); PG8_BAR; PG8_MMA(1, 0, At, B0); PG8_MMA(1, 1, At, B1); PG8_BAR; PG8_SCHED;
            } else {
            PG8_LDB(B0, 0, 0); PG8_SCHED; PG8_LDA(At, 0, 0); PG8_STAGE(PG8_SA(1, 1), a1 + hstep, voffA);
            PG8_WAIT_L(8); PG8_BAR; PG8_WAIT_L(0); PG8_MMA(0, 0, At, B0); PG8_BAR; PG8_SCHED;
            PG8_LDB(B1, 0, 1); PG8_STAGE(PG8_SB(0, 0), b2, voffB);
            PG8_BAR; PG8_WAIT_L(0); PG8_MMA(0, 1, At, B1); PG8_BAR;
            PG8_LDA(At, 0, 1); PG8_STAGE(PG8_SA(0, 0), a2, voffA);
            PG8_BAR; PG8_WAIT_L(0); PG8_MMA(1, 0, At, B0); PG8_BAR; PG8_SCHED;
            PG8_STAGE(PG8_SB(0, 1), b2 + hstep, voffB);
            PG8_WAIT_V(6); PG8_BAR; PG8_MMA(1, 1, At, B1); PG8_BAR;
            PG8_LDB(B0, 1, 0); PG8_SCHED; PG8_LDA(At, 1, 0); PG8_STAGE(PG8_SA(0, 1), a2 + hstep, voffA);
            PG8_WAIT_L(8); PG8_BAR; PG8_WAIT_L(0); PG8_MMA(0, 0, At, B0); PG8_BAR; PG8_SCHED;
            PG8_LDB(B1, 1, 1); PG8_STAGE(PG8_SB(1, 0), b3, voffB);
            PG8_BAR; PG8_WAIT_L(0); PG8_MMA(0, 1, At, B1); PG8_BAR;
            PG8_LDA(At, 1, 1); PG8_STAGE(PG8_SA(1, 0), a3, voffA);
            PG8_BAR; PG8_WAIT_L(0); PG8_MMA(1, 0, At, B0); PG8_BAR; PG8_SCHED;
            PG8_STAGE(PG8_SB(1, 1), b3 + hstep, voffB);
            PG8_WAIT_V(6); PG8_BAR; PG8_MMA(1, 1, At, B1); PG8_BAR;
            }
        }
        if constexpr (ALIGN_EPI) { if (wr == 0) PG8_BAR; }
        if constexpr (!Epi::AFTER_DRAIN) { E(acc, cur, wr, wc, fr, fq); S.done(cur); }
        if (!has_next) break;
#pragma unroll
        for (int a = 0; a < 2; ++a)
#pragma unroll
            for (int b = 0; b < 2; ++b)
#pragma unroll
                for (int m = 0; m < 4; ++m)
#pragma unroll
                    for (int n = 0; n < 2; ++n) acc[a][b][m][n] = (f32x4){0.f, 0.f, 0.f, 0.f};
        cur = nxt; cA = nA; cB = nB; ++ui;
        if constexpr (ALIGN_EPI) { if (wr == 1) PG8_BAR; }
    }
    PG8_WAIT_V(0);
    if constexpr (!ALIGN_EPI) { if (wr == 0) PG8_BAR; }
    PG8_BAR;
    if constexpr (Epi::AFTER_DRAIN) { E.fused(acc, cur, wr, wc, fr, fq, lds, wid, lane); S.done(cur); }
#undef PG8_SA
#undef PG8_SB
#undef PG8_STAGE
#undef PG8_LDA
#undef PG8_LDB
#undef PG8_MMA
#undef PG8_WAIT_V
#undef PG8_WAIT_L
#undef PG8_BAR
#undef PG8_SCHED
}
}
#include <hip/hip_cooperative_groups.h>
#ifndef PROBE_DUP
#define PROBE_DUP 0
#endif
#define REP(bit) for (int rep_ = 0; rep_ < ((PROBE_DUP & (bit)) ? 2 : 1); ++rep_)
#ifndef MK_N_LAUNCHES
#define MK_N_LAUNCHES 1
#endif

constexpr int NWAVES = 8;
constexpr int DEPTH = 4, BATCH = 16, SEQ = 2048, D = 1024, INC = 2560, FF = 3072, LW = 512;
constexpr int PW = 2048;
constexpr int M = BATCH * SEQ;
constexpr int NG = 4, GX = 8 / NG;
constexpr int BH = BATCH / NG, MH = M / NG;
constexpr int CH = 128, NCH = SEQ / CH;
constexpr size_t MiB = 1u << 20;
constexpr size_t WS_CTL = 0, CTL_ZERO_BYTES = 64 * 1024;
constexpr size_t WS_WA = 2 * MiB, WS_WX = WS_WA + 512 * 1024;
constexpr size_t WS_SSQ1 = 3 * MiB, WS_SSQ2 = 5 * MiB;
constexpr size_t WS_EH = 7 * MiB, WS_EP = 8 * MiB;
constexpr size_t WS_FIX = 9 * MiB;
constexpr size_t WS_WIN = 20 * MiB, WS_WOUT = 40 * MiB, WS_WUG = 48 * MiB, WS_WDN = 96 * MiB;
constexpr size_t WS_HB = 120 * MiB, WS_Y = 184 * MiB, WS_R = 248 * MiB, R_HALF = (192 / NG) * MiB;
constexpr size_t R_HLOC = (128 / NG) * MiB, R_PCUM = (160 / NG) * MiB, WS_END = WS_R + NG * R_HALF;
static_assert(WS_FIX + (size_t)(M / 256) * 6 * FF * 4 <= WS_WIN && (size_t)MH * PW * 2 <= R_HLOC && R_HLOC + (size_t)MH * LW * 2 <= R_PCUM && R_PCUM + (size_t)MH * LW * 2 <= R_HALF && (size_t)MH * FF * 2 <= R_HALF, "ws map");
constexpr int CW_BAR = 1024;
constexpr int CW_FLAG = 15360;
constexpr int RING_BYTES = 131072, XCH_OFF = RING_BYTES, MISC_OFF = XCH_OFF + 8192, LDS_BYTES = 147456;

#define GAS __attribute__((address_space(1)))
#define LAS __attribute__((address_space(3)))
typedef unsigned short bf16;
typedef unsigned v4u __attribute__((ext_vector_type(4)));
typedef float f32x4 __attribute__((ext_vector_type(4)));
typedef short bf16x8 __attribute__((ext_vector_type(8)));
typedef GAS unsigned gu32;
typedef GAS unsigned long long gu64;
#define RLX_AGENT __ATOMIC_RELAXED, __HIP_MEMORY_SCOPE_AGENT
#define LDS_WAIT() asm volatile("s_waitcnt lgkmcnt(0)" ::: "memory")
#define VM_WAIT() asm volatile("s_waitcnt vmcnt(0)" ::: "memory")
__device__ __forceinline__ unsigned long long rt() { return __builtin_amdgcn_s_memrealtime(); }
__device__ __forceinline__ unsigned f2bf(float f) { unsigned u = __builtin_bit_cast(unsigned, f); return (u + 0x7fffu + ((u >> 16) & 1u)) >> 16; }
__device__ __forceinline__ unsigned pk2(float lo, float hi) { return f2bf(lo) | (f2bf(hi) << 16); }

#define XB_TMO      128
#define XB_XCNT(j)  (256  + 64 * (j))
#define XB_XSUB(j)  (1280 + 64 * (j))
#define XB_XGEN(j)  (2304 + 64 * (j))
#define XB_TOP      3328
#define XB_TOPGEN   3392
#define XCD_BAR_WORDS 3456
#define XB_SPIN_CAP (1u << 18)

__device__ __forceinline__ unsigned xb_ld(unsigned* p)              { return __hip_atomic_load(p, __ATOMIC_RELAXED, __HIP_MEMORY_SCOPE_AGENT); }
__device__ __forceinline__ unsigned xb_add(unsigned* p, unsigned v) { return __hip_atomic_fetch_add(p, v, __ATOMIC_RELAXED, __HIP_MEMORY_SCOPE_AGENT); }
__device__ __forceinline__ unsigned xb_xcc_id() { return (unsigned)__builtin_amdgcn_s_getreg((3 << 11) | 20) & 0xFu; }
#define XB_SPIN(cond, bar) do { unsigned _sp = 0; while (cond) { __builtin_amdgcn_s_sleep(1); \
    if ((++_sp & 255u) == 0u) { if (xb_ld(&(bar)[XB_TMO])) break; if (_sp > XB_SPIN_CAP) { atomicAdd(&(bar)[XB_TMO], 1u); break; } } } } while (0)

struct XcdBarrier {
    unsigned* bar; unsigned x;
    volatile LAS unsigned* st;
    unsigned expect;
};

__device__ __forceinline__ XcdBarrier xcd_barrier_post(unsigned* bar, volatile LAS unsigned* st, unsigned expect) {
    XcdBarrier b; b.bar = bar; b.x = xb_xcc_id(); b.st = st; b.expect = expect;
    if (threadIdx.x == 0) (void)xb_add(&bar[XB_XCNT(b.x)], 1u);
    return b;
}
__device__ __forceinline__ void xcd_barrier_complete(unsigned* bar, unsigned x, unsigned& nloc, unsigned& nx, unsigned G) {
    unsigned sum, cnt, mine, sp = 0u;
    for (;;) {
        sum = 0u; cnt = 0u; mine = 0u;
#pragma unroll
        for (unsigned j = 0; j < 16; ++j) { const unsigned c = xb_ld(&bar[XB_XCNT(j)]); sum += c; cnt += (c > 0u) ? 1u : 0u; mine = (j == x) ? c : mine; }
        if (sum == G) break;
        __builtin_amdgcn_s_sleep(1);
        if ((++sp & 255u) == 0u) { if (xb_ld(&bar[XB_TMO])) break; if (sp > XB_SPIN_CAP) { atomicAdd(&bar[XB_TMO], 1u); break; } }
    }
    nloc = mine > 0u ? mine : 1u; nx = cnt > 0u ? cnt : 1u;
}

__device__ __forceinline__ void xcd_barrier(const XcdBarrier& b) {
    asm volatile("s_waitcnt vmcnt(0)" ::: "memory");
    __syncthreads();
    if (threadIdx.x == 0) {
        unsigned* bar = b.bar;
        __builtin_amdgcn_s_waitcnt(0);
        unsigned nloc = b.st[0], nx = b.st[1];
        if (nloc == 0u) { xcd_barrier_complete(bar, b.x, nloc, nx, b.expect); b.st[0] = nloc; b.st[1] = nx; }
        const unsigned old = xb_add(&bar[XB_XSUB(b.x)], 1u);
        const unsigned gen = old / nloc;
        if (old + 1u == (gen + 1u) * nloc) {
            __builtin_amdgcn_fence(__ATOMIC_RELEASE, "agent");
            asm volatile("s_waitcnt vmcnt(0)" ::: "memory");
            const unsigned og = xb_add(&bar[XB_TOP], 1u);
            const unsigned tg = og / nx;
            if (og + 1u == (tg + 1u) * nx) xb_add(&bar[XB_TOPGEN], 1u);
            else XB_SPIN(xb_ld(&bar[XB_TOPGEN]) == tg, bar);
            __builtin_amdgcn_fence(__ATOMIC_ACQUIRE, "agent");
            xb_add(&bar[XB_XGEN(b.x)], 1u);
            asm volatile("s_waitcnt vmcnt(0)" ::: "memory");
        } else {
            XB_SPIN(xb_ld(&bar[XB_XGEN(b.x)]) == gen, bar);
            __builtin_amdgcn_fence(__ATOMIC_ACQUIRE, "agent");
            asm volatile("s_waitcnt vmcnt(0)" ::: "memory");
        }
    }
    __syncthreads();
}

struct Args {
    const float* x; const float* norm1_g; const float* w_in; const float* lru_conv_w; const float* lru_conv_b; const float* lru_w_a; const float* lru_b_a;
    const float* lru_w_x; const float* lru_b_x; const float* lru_lambda; const float* sc_conv_w; const float* lru_out_g; const float* sc_out_g; const float* w_out;
    const float* norm2_g; const float* mlp_w_up; const float* mlp_w_gate; const float* mlp_conv_w; const float* mlp_conv_b; const float* mlp_w_down; const float* final_g;
    float* out; unsigned char* ws; int ph_lo, ph_hi;
};
__device__ __forceinline__ float wave_sum(float v) {
#pragma unroll
    for (int o = 1; o < 64; o <<= 1) v += __shfl_xor(v, o);
    return v;
}
__device__ __forceinline__ float bf2f(unsigned short b) { return __builtin_bit_cast(float, (unsigned)b << 16); }
__device__ __forceinline__ float bflo(unsigned w) { return __builtin_bit_cast(float, w << 16); }
__device__ __forceinline__ float bfhi(unsigned w) { return __builtin_bit_cast(float, w & 0xffff0000u); }
__device__ __forceinline__ void unpack8(v4u w, float (&f)[8]) { f[0] = bflo(w.x); f[1] = bfhi(w.x); f[2] = bflo(w.y); f[3] = bfhi(w.y); f[4] = bflo(w.z); f[5] = bfhi(w.z); f[6] = bflo(w.w); f[7] = bfhi(w.w); }
__device__ __forceinline__ v4u pack8(const float (&f)[8]) { v4u w; w.x = pg8::cvt_pk_bf16(f[0], f[1]); w.y = pg8::cvt_pk_bf16(f[2], f[3]); w.z = pg8::cvt_pk_bf16(f[4], f[5]); w.w = pg8::cvt_pk_bf16(f[6], f[7]); return w; }

__device__ __forceinline__ void p0_tile_load(const float* W, int N, int k0, int n0, const float* gain, LAS float* scr, int lane) {
    const int kq = lane >> 3, n4 = (lane & 7) * 4;
    f32x4 v[8];
#pragma unroll
    for (int i = 0; i < 8; ++i) v[i] = *(const GAS f32x4*)(W + (size_t)(k0 + kq + 8 * i) * N + n0 + n4);
#pragma unroll
    for (int i = 0; i < 8; ++i) { const int kk = kq + 8 * i; const float g = gain ? gain[k0 + kk] : 1.0f; LAS float* d = scr + kk * 33 + n4; d[0] = v[i].x * g; d[1] = v[i].y * g; d[2] = v[i].z * g; d[3] = v[i].w * g; }
    LDS_WAIT(); asm volatile("" ::: "memory");
}
__device__ __forceinline__ void p0_tile_store(bf16* WT, int K, int k0, int rbase, LAS float* scr, int lane) {
    const int c = lane & 7;
#pragma unroll
    for (int j = 0; j < 4; ++j) { const int n = (lane >> 3) + 8 * j; const LAS float* s = scr + (8 * c) * 33 + n;
        v4u o; o.x = pk2(s[0 * 33], s[1 * 33]); o.y = pk2(s[2 * 33], s[3 * 33]); o.z = pk2(s[4 * 33], s[5 * 33]); o.w = pk2(s[6 * 33], s[7 * 33]);
        *(GAS v4u*)(WT + (size_t)(rbase + n) * K + k0 + 8 * c) = o; }
    LDS_WAIT(); asm volatile("" ::: "memory");
}
__device__ __forceinline__ void p0_transpose_item(const float* W, int K, int N, bf16* WT, int row_off, const float* gain, LAS float* scr, int item, int lane) {
    const int nblk = N / 32, kb = item / nblk, nb = item % nblk, k0 = 64 * kb, n0 = 32 * nb;
    p0_tile_load(W, N, k0, n0, gain, scr, lane); p0_tile_store(WT, K, k0, row_off + n0, scr, lane);
}
__device__ __forceinline__ void p0_transpose_item_ug(const float* W, bf16* WT, int half, const float* gain, LAS float* scr, int item, int lane) {
    constexpr int K = D, N = FF;
    const int nblk = N / 32, kb = item / nblk, nb = item % nblk, k0 = 64 * kb, n0 = 32 * nb;
    p0_tile_load(W, N, k0, n0, gain, scr, lane); p0_tile_store(WT, K, k0, 256 * (n0 / 128) + (n0 % 128) + 128 * half, scr, lane);
}

__global__ void __launch_bounds__(NWAVES * 64, 2) mk_fwd(Args args) {
    extern __shared__ __attribute__((aligned(16))) unsigned char lds_raw[];
    LAS unsigned char* lds = (LAS unsigned char*)lds_raw;
    volatile LAS unsigned* MISC = (volatile LAS unsigned*)(lds + MISC_OFF);
    const int tid_k = threadIdx.x, lane_k = tid_k & 63, wave = __builtin_amdgcn_readfirstlane(tid_k >> 6);
    const int bx = blockIdx.x, half = (bx & 7) / GX;
    const int G = gridDim.x / NG;
    const int chh = (bx >> 3) * GX + (bx & (GX - 1));
    const int vcu = (bx & (GX - 1)) * (G / GX) + (bx >> 3);
    const int gw = vcu * NWAVES + wave, NGW = G * NWAVES;
    unsigned char* ws = args.ws;
    for (int u = tid_k; u < (LDS_BYTES - XCH_OFF) / 4; u += NWAVES * 64) ((LAS unsigned*)(lds + XCH_OFF))[u] = 0u;
    __syncthreads();
    XcdBarrier bar = xcd_barrier_post((unsigned*)(ws + WS_CTL) + CW_BAR + half * XCD_BAR_WORDS, MISC + 8, (unsigned)G);
    unsigned* xflag = (unsigned*)(ws + WS_CTL) + CW_FLAG;
    bf16* Wa_t = (bf16*)(ws + WS_WA); bf16* Wx_t = (bf16*)(ws + WS_WX);
    float* ssq1 = (float*)(ws + WS_SSQ1) + (size_t)half * MH * 16; float* ssq2 = (float*)(ws + WS_SSQ2) + (size_t)half * MH * 16;
    float* Eh = (float*)(ws + WS_EH) + (size_t)half * BH * NCH * LW; float* EP = (float*)(ws + WS_EP) + (size_t)half * BH * NCH * LW; float* fixb = (float*)(ws + WS_FIX) + (size_t)half * (MH / 256) * 6 * FF;
    bf16* Win_t = (bf16*)(ws + WS_WIN); bf16* Wout_t = (bf16*)(ws + WS_WOUT); bf16* Wug_t = (bf16*)(ws + WS_WUG); bf16* Wdn_t = (bf16*)(ws + WS_WDN);
    unsigned char* rh = ws + WS_R + (size_t)half * R_HALF;
    bf16* hb = (bf16*)(ws + WS_HB) + (size_t)half * MH * D; bf16* yb = (bf16*)(ws + WS_Y) + (size_t)half * MH * D; bf16* proj = (bf16*)rh; bf16* act = (bf16*)rh;
    bf16* hloc = (bf16*)(rh + R_HLOC); bf16* pcum = (bf16*)(rh + R_PCUM);
    const float* xin = args.x + (size_t)half * MH * D; float* outp = args.out + (size_t)half * MH * D;
    const int lo = args.ph_lo, hi = args.ph_hi;
    int ph = 0;
#define RUN(k) (lo <= (k) && (k) < hi)
#define SEAM(k) do { if (RUN(k) && RUN((k) + 1)) xcd_barrier(bar); } while (0)

    if (RUN(ph)) REP(1) {
        int lane; asm volatile("v_mbcnt_lo_u32_b32 %0, -1, 0\n\tv_mbcnt_hi_u32_b32 %0, -1, %0" : "=v"(lane));
        LAS float* scr = (LAS float*)(lds + wave * 16384);
        constexpr int I_IN = (D / 64) * (INC / 32), I_OUT = (D / 64) * (D / 32), I_UP = (D / 64) * (FF / 32), I_DN = (FF / 64) * (D / 32), I_G = 2;
        constexpr int PER_LAYER = I_IN + I_OUT + 2 * I_UP + I_DN;
        const int TB0 = 0, TB1 = PER_LAYER, TB2 = PER_LAYER + (DEPTH - 1) * PER_LAYER * 5 / 18, TB3 = PER_LAYER + (DEPTH - 1) * PER_LAYER * 11 / 18, TB4 = DEPTH * PER_LAYER;
        const int tlo = half == 0 ? TB0 : half == 1 ? TB1 : half == 2 ? TB2 : TB3, thi = half == 0 ? TB1 : half == 1 ? TB2 : half == 2 ? TB3 : TB4;
        const int nmine = (thi - tlo) + (half == 0 ? DEPTH * 8 * 2 * I_G : 0);
        for (int it = gw; it < nmine; it += NGW) {
            int l, r;
            if (it >= thi - tlo) { r = it - (thi - tlo); l = r / (8 * 2 * I_G); r %= 8 * 2 * I_G;
                const int hd = r / (2 * I_G), mat = (r / I_G) & 1, sub = r % I_G; const size_t o = ((size_t)l * 8 + hd) * 64 * 64;
                p0_transpose_item((mat ? args.lru_w_x : args.lru_w_a) + o, 64, 64, (mat ? Wx_t : Wa_t) + o, 0, nullptr, scr, sub, lane); continue; }
            l = (it + tlo) / PER_LAYER; r = (it + tlo) % PER_LAYER;
            if (r < I_IN) { const int kb = r / (INC / 32), n0 = 32 * (r % (INC / 32));
                int rb = n0; if (n0 >= 2048) { const int f = n0 - 2048; rb = 1536 + 256 * (f / 128) + 128 + (f % 128); } else if (n0 >= 1536) { const int f = n0 - 1536; rb = 1536 + 256 * (f / 128) + (f % 128); }
                p0_tile_load(args.w_in + (size_t)l * D * INC, INC, 64 * kb, n0, args.norm1_g + l * D, scr, lane); p0_tile_store(Win_t + (size_t)l * INC * D, D, 64 * kb, rb, scr, lane); continue; } r -= I_IN;
            if (r < I_OUT) { const int kb = r / (D / 32); const float* g = (kb < 8) ? args.lru_out_g + l * LW + 0 : args.sc_out_g + l * LW - LW;
                p0_transpose_item(args.w_out + (size_t)l * D * D, D, D, Wout_t + (size_t)l * D * D, 0, g, scr, r, lane); continue; } r -= I_OUT;
            if (r < I_UP) { p0_transpose_item_ug(args.mlp_w_up + (size_t)l * D * FF, Wug_t + (size_t)l * 2 * FF * D, 0, args.norm2_g + l * D, scr, r, lane); continue; } r -= I_UP;
            if (r < I_UP) { p0_transpose_item_ug(args.mlp_w_gate + (size_t)l * D * FF, Wug_t + (size_t)l * 2 * FF * D, 1, args.norm2_g + l * D, scr, r, lane); continue; } r -= I_UP;
            p0_transpose_item(args.mlp_w_down + (size_t)l * FF * D, FF, D, Wdn_t + (size_t)l * D * FF, 0, nullptr, scr, r, lane);
        }
        for (int m = gw; m < MH; m += NGW) {
            const GAS f32x4* xr = (const GAS f32x4*)(xin + (size_t)m * D) + lane;
            f32x4 v[4]; float s = 0.f;
#pragma unroll
            for (int j = 0; j < 4; ++j) { v[j] = xr[64 * j]; s += (v[j].x * v[j].x + v[j].y * v[j].y) + (v[j].z * v[j].z + v[j].w * v[j].w); }
            s = wave_sum(s);
            GAS unsigned long long* o8 = (GAS unsigned long long*)(hb + (size_t)m * D) + lane;
#pragma unroll
            for (int j = 0; j < 4; ++j) o8[64 * j] = (unsigned long long)pg8::cvt_pk_bf16(v[j].x, v[j].y) | ((unsigned long long)pg8::cvt_pk_bf16(v[j].z, v[j].w) << 32);
            if (lane < 4) *(f32x4*)(ssq1 + (size_t)m * 16 + 4 * lane) = (f32x4){lane == 0 ? s : 0.f, 0.f, 0.f, 0.f};
        }
    }
    if (hi < 0) cooperative_groups::this_grid().sync();
    xcd_barrier(bar);
    if (vcu == 0 && tid_k == 0) __hip_atomic_store(xflag + 64 * half, 1u, __ATOMIC_RELEASE, __HIP_MEMORY_SCOPE_AGENT);
#define WAIT_HALF(h) do { if (tid_k == 0) { unsigned sp_ = 0; while (__hip_atomic_load(xflag + 64 * (h), __ATOMIC_RELAXED, __HIP_MEMORY_SCOPE_AGENT) == 0u && ++sp_ < (1u << 22)) __builtin_amdgcn_s_sleep(8); \
        __builtin_amdgcn_fence(__ATOMIC_ACQUIRE, "agent"); asm volatile("s_waitcnt vmcnt(0)" ::: "memory"); } __syncthreads(); } while (0)
    if (half != 0) WAIT_HALF(0);
    ++ph;

    for (int l = 0; l < DEPTH; ++l) {
        if (RUN(ph)) {
            if (l == 1) { for (int h2 = 1; h2 < NG; ++h2) if (h2 != half) WAIT_HALF(h2); }
            pg8::Gemm g{hb, Win_t + (size_t)l * INC * D, MH, INC, D}; pg8::StaticOrder S; S.init(MH, INC, G, chh, GX);
            pg8::EpiProj E{proj, PW, ssq1, 6, (LAS float*)(lds + XCH_OFF)};
            REP(2) pg8::gemm_phase<pg8::EpiProj, pg8::StaticOrder, true, true>(lds, g, S, E);
            if (tid_k == 0) *(volatile LAS int*)(lds + XCH_OFF + 1536 * 4) = 0;
        }
        SEAM(ph); ++ph;
        if (RUN(ph)) {
            int lane; asm volatile("v_mbcnt_lo_u32_b32 %0, -1, 0\n\tv_mbcnt_hi_u32_b32 %0, -1, %0" : "=v"(lane));
            const int fr = lane & 15, fq = lane >> 4, ch = 64 * wave + lane;
            LAS bf16* sA = (LAS bf16*)(lds + wave * 12288);
            LAS float* sR = (LAS float*)(lds + wave * 12288 + 2560);
            LAS float* sI = sR + 16 * 68;
            const float cw0 = args.lru_conv_w[(l * 4 + 0) * LW + ch], cw1 = args.lru_conv_w[(l * 4 + 1) * LW + ch], cw2 = args.lru_conv_w[(l * 4 + 2) * LW + ch], cw3 = args.lru_conv_w[(l * 4 + 3) * LW + ch];
            const float cbias = args.lru_conv_b[l * LW + ch], ba = args.lru_b_a[l * LW + ch], bx = args.lru_b_x[l * LW + ch];
            const float c2 = -8.0f * log1pf(__expf(-args.lru_lambda[l * LW + ch])) * 1.44269504089f;
            pg8::bf16x8 Ba[4][2], Bx[4][2];
#pragma unroll
            for (int nt = 0; nt < 4; ++nt)
#pragma unroll
                for (int ks = 0; ks < 2; ++ks) { const size_t o = (((size_t)l * 8 + wave) * 64 + 16 * nt + fr) * 64 + 32 * ks + 8 * fq;
                    Ba[nt][ks] = *(const pg8::bf16x8*)(Wa_t + o); Bx[nt][ks] = *(const pg8::bf16x8*)(Wx_t + o); }
            REP(4) for (int item = vcu; item < BH * NCH; item += G) {
                const int b = item % BH, c = item / BH;
                const size_t t0 = (size_t)b * SEQ + (size_t)c * CH;
                float xm3 = 0.f, xm2 = 0.f, xm1 = 0.f;
                if (c > 0) { xm3 = bf2f(proj[(t0 - 3) * PW + ch]); xm2 = bf2f(proj[(t0 - 2) * PW + ch]); xm1 = bf2f(proj[(t0 - 1) * PW + ch]); }
                float h = 0.f, P = 1.f;
                unsigned short xr[16];
#pragma unroll
                for (int j = 0; j < 16; ++j) xr[j] = proj[(t0 + j) * PW + ch];
#pragma unroll 1
                for (int g = 0; g < CH / 16; ++g) {
                    const size_t tg = t0 + 16 * g;
                    float xa[16];
#pragma unroll
                    for (int j = 0; j < 16; ++j) { const float xv = bf2f(xr[j]); xa[j] = cw0 * xm3 + cw1 * xm2 + cw2 * xm1 + cw3 * xv + cbias; xm3 = xm2; xm2 = xm1; xm1 = xv; }
                    { const size_t tn = (g + 1 < CH / 16) ? tg + 16 : tg;
#pragma unroll
                      for (int j = 0; j < 16; ++j) xr[j] = proj[(tn + j) * PW + ch]; }
#pragma unroll
                    for (int j = 0; j < 16; ++j) sA[j * 72 + lane] = (bf16)f2bf(xa[j]);
                    LDS_WAIT(); asm volatile("" ::: "memory");
                    const pg8::bf16x8 a0 = *(const LAS pg8::bf16x8*)(sA + fr * 72 + 8 * fq), a1 = *(const LAS pg8::bf16x8*)(sA + fr * 72 + 32 + 8 * fq);
                    f32x4 racc[4], iacc[4];
#pragma unroll
                    for (int nt = 0; nt < 4; ++nt) { racc[nt] = (f32x4){0.f, 0.f, 0.f, 0.f}; iacc[nt] = racc[nt];
                        racc[nt] = __builtin_amdgcn_mfma_f32_16x16x32_bf16(a0, Ba[nt][0], racc[nt], 0, 0, 0); racc[nt] = __builtin_amdgcn_mfma_f32_16x16x32_bf16(a1, Ba[nt][1], racc[nt], 0, 0, 0);
                        iacc[nt] = __builtin_amdgcn_mfma_f32_16x16x32_bf16(a0, Bx[nt][0], iacc[nt], 0, 0, 0); iacc[nt] = __builtin_amdgcn_mfma_f32_16x16x32_bf16(a1, Bx[nt][1], iacc[nt], 0, 0, 0); }
#pragma unroll
                    for (int nt = 0; nt < 4; ++nt)
#pragma unroll
                        for (int j = 0; j < 4; ++j) { sR[(4 * fq + j) * 68 + 16 * nt + fr] = racc[nt][j]; sI[(4 * fq + j) * 68 + 16 * nt + fr] = iacc[nt][j]; }
                    LDS_WAIT(); asm volatile("" ::: "memory");
                    {
                        typedef float f32x2v __attribute__((ext_vector_type(2)));
                        const float nk = -1.44269504089f;
                        bf16* hrow = hloc + tg * LW; bf16* prow = pcum + tg * LW;
#pragma unroll
                        for (int t = 0; t < 16; t += 2) {
                            const f32x2v sr = (f32x2v){sR[t * 68 + lane], sR[(t + 1) * 68 + lane]}, si = (f32x2v){sI[t * 68 + lane], sI[(t + 1) * 68 + lane]};
                            const f32x2v z1 = sr * nk + (nk * ba), z2 = si * nk + (nk * bx);
                            f32x2v e1, e2; e1.x = __builtin_amdgcn_exp2f(z1.x); e1.y = __builtin_amdgcn_exp2f(z1.y); e2.x = __builtin_amdgcn_exp2f(z2.x); e2.y = __builtin_amdgcn_exp2f(z2.y);
                            e1 = e1 + 1.0f; e2 = e2 + 1.0f;
                            f32x2v r, ig; r.x = __builtin_amdgcn_rcpf(e1.x); r.y = __builtin_amdgcn_rcpf(e1.y); ig.x = __builtin_amdgcn_rcpf(e2.x); ig.y = __builtin_amdgcn_rcpf(e2.y);
                            const f32x2v la = r * c2; f32x2v a; a.x = __builtin_amdgcn_exp2f(la.x); a.y = __builtin_amdgcn_exp2f(la.y);
                            const f32x2v m2 = 1.0f - a * a;
                            f32x2v mult; mult.x = __builtin_amdgcn_sqrtf(m2.x); mult.y = __builtin_amdgcn_sqrtf(m2.y);
                            const f32x2v bb = (mult * ig) * (f32x2v){xa[t], xa[t + 1]};
                            h = a.x * h + bb.x; P *= a.x;
                            { const unsigned w = pg8::cvt_pk_bf16(h, P); hrow[t * LW + ch] = (bf16)w; prow[t * LW + ch] = (bf16)(w >> 16); }
                            h = a.y * h + bb.y; P *= a.y;
                            { const unsigned w = pg8::cvt_pk_bf16(h, P); hrow[(t + 1) * LW + ch] = (bf16)w; prow[(t + 1) * LW + ch] = (bf16)(w >> 16); }
                        }
                    }
                    LDS_WAIT(); asm volatile("" ::: "memory");
                }
                Eh[((size_t)b * NCH + c) * LW + ch] = h; EP[((size_t)b * NCH + c) * LW + ch] = P;
            }
        }
        SEAM(ph); ++ph;
        if (RUN(ph)) {
            int lane; asm volatile("v_mbcnt_lo_u32_b32 %0, -1, 0\n\tv_mbcnt_hi_u32_b32 %0, -1, %0" : "=v"(lane));
            LAS float* sH = (LAS float*)lds;
            LAS float* sW = sH + 512;
            for (int i = wave * 64 + lane; i < 3 * LW; i += NWAVES * 64) sW[i] = args.sc_conv_w[l * 3 * LW + i];
            __syncthreads();
            REP(8) for (int item = vcu; item < BH * NCH; item += G) {
                const int b = item % BH, c = item / BH;
                {
                    const int ch = 64 * wave + lane; const float* ep = EP + (size_t)b * NCH * LW + ch; const float* eh = Eh + (size_t)b * NCH * LW + ch;
                    float pj[NCH], hj[NCH];
#pragma unroll
                    for (int j = 0; j < NCH - 1; ++j) { pj[j] = 1.f; hj[j] = 0.f; if (j < c) { pj[j] = ep[j * LW]; hj[j] = eh[j * LW]; } }
                    float Hc = 0.f;
#pragma unroll
                    for (int j = 0; j < NCH - 1; ++j) Hc = pj[j] * Hc + hj[j];
                    sH[ch] = Hc;
                }
                __syncthreads();
                float H[8];
                { const f32x4 ha = *(const LAS f32x4*)(sH + 8 * lane), hb4 = *(const LAS f32x4*)(sH + 8 * lane + 4);
#pragma unroll
                  for (int e = 0; e < 4; ++e) { H[e] = ha[e]; H[4 + e] = hb4[e]; } }
                const int s0 = c * CH + (CH / NWAVES) * wave;
                const size_t t0 = (size_t)b * SEQ + s0;
                float cv1[8], cv2[8];
#pragma unroll
                for (int e = 0; e < 8; ++e) { cv1[e] = 0.f; cv2[e] = 0.f; }
                if (s0 > 0) { unpack8(*(const v4u*)(proj + (t0 - 1) * PW + 1536 + 8 * lane), cv1); unpack8(*(const v4u*)(proj + (t0 - 2) * PW + 1536 + 8 * lane), cv2); }
#pragma unroll 1
                for (int hf = 0; hf < CH / NWAVES / 4; ++hf) {
                    v4u raw[4][5];
#pragma unroll
                    for (int tt = 0; tt < 4; ++tt) { const size_t t = t0 + 4 * hf + tt;
                        raw[tt][0] = *(const v4u*)(hloc + t * LW + 8 * lane); raw[tt][1] = *(const v4u*)(pcum + t * LW + 8 * lane);
                        raw[tt][2] = *(const v4u*)(proj + t * PW + 512 + 8 * lane); raw[tt][3] = *(const v4u*)(proj + t * PW + 1024 + 8 * lane);
                        raw[tt][4] = *(const v4u*)(proj + t * PW + 1536 + 8 * lane); }
#pragma unroll
                    for (int tt = 0; tt < 4; ++tt) { const size_t t = t0 + 4 * hf + tt;
                        float hl[8], pc[8], gt[8], sb[8], cvn[8], ya[8], yv[8];
                        unpack8(raw[tt][0], hl); unpack8(raw[tt][1], pc); unpack8(raw[tt][2], gt); unpack8(raw[tt][3], sb); unpack8(raw[tt][4], cvn);
                        float sa = 0.f, sbq = 0.f, w0[8], w1[8], w2[8];
                        { const f32x4 a0 = *(const LAS f32x4*)(sW + 8 * lane), a1 = *(const LAS f32x4*)(sW + 8 * lane + 4), b0 = *(const LAS f32x4*)(sW + LW + 8 * lane), b1 = *(const LAS f32x4*)(sW + LW + 8 * lane + 4),
                                      c0 = *(const LAS f32x4*)(sW + 2 * LW + 8 * lane), c1 = *(const LAS f32x4*)(sW + 2 * LW + 8 * lane + 4);
#pragma unroll
                          for (int e = 0; e < 4; ++e) { w0[e] = a0[e]; w0[4 + e] = a1[e]; w1[e] = b0[e]; w1[4 + e] = b1[e]; w2[e] = c0[e]; w2[4 + e] = c1[e]; } }
#pragma unroll
                        for (int e = 0; e < 8; ++e) { const float hh = hl[e] + pc[e] * H[e]; ya[e] = hh * pg8::gelu_tanh(gt[e]); sa += ya[e] * ya[e];
                            const float cv = cvn[e]; yv[e] = sb[e] * (w0[e] * cv2[e] + w1[e] * cv1[e] + w2[e] * cv); sbq += yv[e] * yv[e]; cv2[e] = cv1[e]; cv1[e] = cv; }
                        sa = wave_sum(sa); sbq = wave_sum(sbq);
                        const float ra = __builtin_amdgcn_rsqf(sa * (1.0f / LW) + pg8::RMS_EPS), rb = __builtin_amdgcn_rsqf(sbq * (1.0f / LW) + pg8::RMS_EPS);
#pragma unroll
                        for (int e = 0; e < 8; ++e) { ya[e] *= ra; yv[e] *= rb; }
                        *(v4u*)(yb + t * D + 8 * lane) = pack8(ya); *(v4u*)(yb + t * D + LW + 8 * lane) = pack8(yv);
                        __builtin_amdgcn_sched_barrier(0);
                    }
                }
                __syncthreads();
            }
        }
        SEAM(ph); ++ph;
        if (RUN(ph)) {
            pg8::Gemm g{yb, Wout_t + (size_t)l * D * D, MH, D, D}; pg8::StaticOrder S; S.init(MH, D, G, chh, GX);
            pg8::EpiRes E{hb, ssq2};
            pg8::gemm_phase<pg8::EpiRes, pg8::StaticOrder, true, true>(lds, g, S, E);
        }
        SEAM(ph); ++ph;
        if (RUN(ph)) {
            pg8::Gemm g{hb, Wug_t + (size_t)l * 2 * FF * D, MH, 2 * FF, D}; pg8::StaticOrder S; S.init(MH, 2 * FF, G, chh, GX);
            pg8::EpiUG E{act, ssq2, args.mlp_conv_w + (size_t)l * 3 * FF, args.mlp_conv_b + (size_t)l * FF, fixb, (LAS float*)(lds + XCH_OFF)};
#if PROBE_DUP & 64
            { pg8::EpiProj E2{act, FF, ssq2, 1000, (LAS float*)(lds + XCH_OFF)}; pg8::gemm_phase<pg8::EpiProj, pg8::StaticOrder, true, true>(lds, g, S, E2); }
#endif
            REP(16) pg8::gemm_phase<pg8::EpiUG, pg8::StaticOrder, true, true>(lds, g, S, E);
            if (tid_k == 0) *(volatile LAS int*)(lds + XCH_OFF + 1536 * 4) = 0;
        }
        SEAM(ph); ++ph;
        if (RUN(ph)) {
            pg8::Gemm g{act, Wdn_t + (size_t)l * D * FF, MH, D, FF}; pg8::StaticOrder S; S.init(MH, D, G, chh, GX);
            {
                const float* cw = args.mlp_conv_w + (size_t)l * 3 * FF; const float* cb = args.mlp_conv_b + (size_t)l * FF;
                int tid = tid_k; asm volatile("" : "+v"(tid));
                pg8::Unit uu;
                for (int ui = 0; S.next(ui, uu); ++ui) {
                    const int pm = uu.pm;
                    for (int i = tid; i < FF / 4; i += NWAVES * 64) {
                        const int f = 4 * i;
                        const float* fb = fixb + (size_t)pm * 6 * FF + f;
                        const f32x4 u0 = *(const f32x4*)(fb), u1 = *(const f32x4*)(fb + FF), g0 = *(const f32x4*)(fb + 2 * FF), g1 = *(const f32x4*)(fb + 3 * FF);
                        f32x4 pm2 = (f32x4){0.f, 0.f, 0.f, 0.f}, pm1 = pm2;
                        if (pm % (SEQ / 256) != 0) { pm2 = *(const f32x4*)(fb - 2 * FF); pm1 = *(const f32x4*)(fb - FF); }
                        const f32x4 w0 = *(const f32x4*)(cw + f), w1 = *(const f32x4*)(cw + FF + f), w2 = *(const f32x4*)(cw + 2 * FF + f), bb = *(const f32x4*)(cb + f);
                        float o0[4], o1[4];
#pragma unroll
                        for (int e = 0; e < 4; ++e) { o0[e] = pg8::gelu_tanh(w0[e] * pm2[e] + w1[e] * pm1[e] + w2[e] * u0[e] + bb[e]) * g0[e];
                                                      o1[e] = pg8::gelu_tanh(w0[e] * pm1[e] + w1[e] * u0[e] + w2[e] * u1[e] + bb[e]) * g1[e]; }
                        typedef unsigned u32x2v __attribute__((ext_vector_type(2)));
                        u32x2v a; a.x = pg8::cvt_pk_bf16(o0[0], o0[1]); a.y = pg8::cvt_pk_bf16(o0[2], o0[3]); *(u32x2v*)(act + (size_t)(pm * 256) * FF + f) = a;
                        a.x = pg8::cvt_pk_bf16(o1[0], o1[1]); a.y = pg8::cvt_pk_bf16(o1[2], o1[3]); *(u32x2v*)(act + (size_t)(pm * 256 + 1) * FF + f) = a;
                    }
                }
                VM_WAIT(); __syncthreads();
            }
            pg8::EpiRes E{hb, ssq1};
            pg8::gemm_phase<pg8::EpiRes, pg8::StaticOrder, true, true>(lds, g, S, E);
        }
        SEAM(ph); ++ph;
    }
    if (RUN(ph)) {
        int lane; asm volatile("v_mbcnt_lo_u32_b32 %0, -1, 0\n\tv_mbcnt_hi_u32_b32 %0, -1, %0" : "=v"(lane));
        f32x4 gf[4];
#pragma unroll
        for (int j = 0; j < 4; ++j) gf[j] = *((const f32x4*)args.final_g + lane + 64 * j);
        for (int m = gw; m < MH; m += NGW) {
            const float pr = (lane < 16) ? ssq1[(size_t)m * 16 + lane] : 0.f;
            const float rs = __builtin_amdgcn_rsqf(wave_sum(pr) * (1.0f / D) + pg8::RMS_EPS);
            const GAS unsigned long long* hr = (const GAS unsigned long long*)(hb + (size_t)m * D) + lane;
            GAS f32x4* xr = (GAS f32x4*)(outp + (size_t)m * D) + lane;
#pragma unroll
            for (int j = 0; j < 4; ++j) { const unsigned long long q = hr[64 * j]; const unsigned qa = (unsigned)q, qb = (unsigned)(q >> 32);
                f32x4 v = (f32x4){bflo(qa), bfhi(qa), bflo(qb), bfhi(qb)}; v = v * rs * gf[j]; xr[64 * j] = v; }
        }
    }
#undef RUN
#undef SEAM
}
constexpr int N_PHASES = 2 + DEPTH * 6;
static_assert(MK_N_LAUNCHES == 1, "the two-half schedule is one cooperative launch");

extern "C" void kernel_launch(void* const* d_in, const int* in_sizes, int n_in, void* d_out, int out_size, void* d_ws, size_t ws_size, hipStream_t stream) {
    static int grid = 0;
    if (grid == 0) {
        if (n_in != 21 || in_sizes[0] != M * D || out_size != M * D || ws_size < WS_END) { fprintf(stderr, "kernel_launch: unexpected shapes (n_in %d, in0 %d, out %d, ws %zu); nothing launched\n", n_in, n_in > 0 ? in_sizes[0] : -1, out_size, ws_size); grid = -1; return; }
        int dev = 0, cus = 0, per_cu = 0;
        if (hipGetDevice(&dev) != hipSuccess || hipDeviceGetAttribute(&cus, hipDeviceAttributeMultiprocessorCount, dev) != hipSuccess) { grid = -1; return; }
        if (hipFuncSetAttribute((const void*)mk_fwd, hipFuncAttributeMaxDynamicSharedMemorySize, LDS_BYTES) != hipSuccess) { fprintf(stderr, "kernel_launch: hipFuncSetAttribute failed\n"); grid = -1; return; }
        if (hipOccupancyMaxActiveBlocksPerMultiprocessor(&per_cu, (const void*)mk_fwd, NWAVES * 64, LDS_BYTES) != hipSuccess || per_cu < 1) { fprintf(stderr, "kernel_launch: occupancy query says %d\n", per_cu); per_cu = 1; }
        (void)hipGetLastError();
        grid = cus;
        if (grid % 8 != 0 || grid < 64) { fprintf(stderr, "kernel_launch: the two-half schedule needs a multiple of 8 workgroups (got %d); nothing launched\n", grid); grid = -1; return; }
    }
    if (grid < 0) return;
    (void)hipMemsetAsync((char*)d_ws + WS_CTL, 0, CTL_ZERO_BYTES, stream);
    Args a{};
    const float** ap = (const float**)&a;
    for (int i = 0; i < 21; ++i) ap[i] = (const float*)d_in[i];
    a.out = (float*)d_out; a.ws = (unsigned char*)d_ws;
#if MK_N_LAUNCHES == 1
    a.ph_lo = 0; a.ph_hi = N_PHASES;
    void* kargs[] = {&a};
    hipError_t e = hipLaunchCooperativeKernel((const void*)mk_fwd, dim3(grid), dim3(NWAVES * 64), kargs, LDS_BYTES, stream);
    if (e != hipSuccess) fprintf(stderr, "kernel_launch: cooperative launch failed: %s (grid %d)\n", hipGetErrorString(e), grid);
#else
    for (int p = 0; p < N_PHASES; ++p) { a.ph_lo = p; a.ph_hi = p + 1; hipLaunchKernelGGL(mk_fwd, dim3(grid), dim3(NWAVES * 64), LDS_BYTES, stream, a); }
#endif
}
```

```cpp
#include <hip/hip_runtime.h>
#include <cstdio>
#include <cstdint>
namespace pg8 {
#define PG8_LAS __attribute__((address_space(3)))
typedef unsigned short bf16_t;
typedef short bf16x8 __attribute__((ext_vector_type(8)));
typedef float f32x4 __attribute__((ext_vector_type(4)));
typedef unsigned u32x4 __attribute__((ext_vector_type(4)));
constexpr int BM = 256, BK = 64, HALF = 128, HTB = HALF * BK * 2  , STAGE_BYTES = 8 * HTB, NXCD = 8, WGM = 8;

__host__ __device__ __forceinline__ int lds_byte(int r, int c) { const int st = (r >> 4) * 2 + (c >> 5), rr = r & 15, cc = c & 31, ob = rr * 64 + cc * 2; return st * 1024 + (ob ^ (((ob >> 9) & 1) << 5)); }
__host__ __device__ __forceinline__ void stage_rc(int b, int& R, int& C) { const int st = b / 1024, sb = b % 1024, swz = sb ^ (((sb >> 9) & 1) << 5); R = (st >> 1) * 16 + swz / 64; C = (st & 1) * 32 + (swz % 64) / 2; }
__host__ __device__ __forceinline__ int perm32(int rho) { const int n = rho >> 4, i = rho & 15; return 8 * (i >> 2) + 4 * n + (i & 3); }

struct Unit { int pm, pn; };
struct Gemm { const bf16_t* A; const bf16_t* Bt; int M, N, K; };

struct StaticOrder {
    int nM, nN, nwg, G, c, nx;
    __host__ __device__ void init(int M, int N, int G_, int c_, int nx_ = NXCD) { nM = M / BM; nN = N / BM; nwg = nM * nN; G = G_; c = c_; nx = nx_; }
    __host__ __device__ bool next(int i, Unit& u) const {
        const long L = (long)i * G + c; if (L >= nwg) return false;
        int wgid = (int)L; { const int q = nwg / nx, r = nwg % nx, xcd = wgid % nx, off = wgid / nx; wgid = (xcd < r ? xcd * (q + 1) : r * (q + 1) + (xcd - r) * q) + off; }
        const int nig = WGM * nN, gid = wgid / nig, fm = gid * WGM, gsz = (nM - fm) < WGM ? (nM - fm) : WGM;
        u.pm = fm + ((wgid % nig) % gsz); u.pn = (wgid % nig) / gsz; return true;
    }
    __device__ __forceinline__ void a_ready(const Unit&) const {}
    __device__ __forceinline__ void done(const Unit&) const {}
};

__device__ __forceinline__ unsigned cvt_pk_bf16(float lo, float hi) { unsigned r; asm volatile("v_cvt_pk_bf16_f32 %0, %1, %2" : "=v"(r) : "v"(lo), "v"(hi)); return r; }
typedef float f32x2 __attribute__((ext_vector_type(2)));
__device__ __forceinline__ f32x2 gelu_pk(f32x2 v) {
    const f32x2 av = __builtin_elementwise_abs(v), d = av * 0.2316418882f + 1.0f;
    f32x2 t; t.x = __builtin_amdgcn_rcpf(d.x); t.y = __builtin_amdgcn_rcpf(d.y);
    f32x2 q = t * 0.5307027145f + (-0.7265760135f); q = q * t + 0.7107068705f; q = q * t + (-0.142248368f); q = q * t + 0.127414796f; q = q * t;
    const f32x2 s = (v * v) * (-0.72134752044f);
    f32x2 e; e.x = __builtin_amdgcn_exp2f(s.x); e.y = __builtin_amdgcn_exp2f(s.y);
    const f32x2 m = v * (q * e), r = v - m;
    f32x2 o; o.x = v.x < 0.f ? m.x : r.x; o.y = v.y < 0.f ? m.y : r.y; return o;
}


constexpr float RMS_EPS = 1e-6f;
__device__ __forceinline__ float dpp_ror1(float v) { return __builtin_bit_cast(float, __builtin_amdgcn_update_dpp(0, __builtin_bit_cast(int, v), 0x121, 0xf, 0xf, false)); }
__device__ __forceinline__ float dpp_ror2(float v) { return __builtin_bit_cast(float, __builtin_amdgcn_update_dpp(0, __builtin_bit_cast(int, v), 0x122, 0xf, 0xf, false)); }
__device__ __forceinline__ float gelu_tanh(float x) {
    const float z = x * (1.0f + 0.044715f * x * x) * (-2.3022081985f);
    return x * __builtin_amdgcn_rcpf(1.0f + __builtin_amdgcn_exp2f(z));
}
__device__ __forceinline__ f32x2 gelu_tanh_pk(f32x2 v) {
    f32x2 t = v * v; t = t * (0.044715f * -2.3022081985f) + (-2.3022081985f);
    const f32x2 z = v * t; f32x2 e; e.x = __builtin_amdgcn_exp2f(z.x); e.y = __builtin_amdgcn_exp2f(z.y); e = e + 1.0f;
    f32x2 r; r.x = __builtin_amdgcn_rcpf(e.x); r.y = __builtin_amdgcn_rcpf(e.y); return v * r;
}
__device__ __forceinline__ void load_rs(const float* ssq, int r0, int fq, float (&rs)[2][4]) {
#pragma unroll
    for (int ai = 0; ai < 2; ++ai)
#pragma unroll
        for (int m = 0; m < 4; ++m) {
            const f32x4 p = *(const f32x4*)(ssq + (size_t)(r0 + ai * HALF + m * 16) * 16 + 4 * fq);
            float s = (p[0] + p[1]) + (p[2] + p[3]);
            s += __shfl_xor(s, 16); s += __shfl_xor(s, 32);
            rs[ai][m] = __builtin_amdgcn_rsqf(s * (1.0f / 1024.0f) + RMS_EPS);
        }
}
__device__ __forceinline__ bool get_rs(PG8_LAS float* xch, const float* ssq, int pm, int row0, int wr, int wc, int fr, int fq, float (&rs)[2][4]) {
    PG8_LAS float* rsbuf = xch + 1280; volatile PG8_LAS int* rstag = (volatile PG8_LAS int*)(xch + 1536);
    const bool miss = (rstag[0] != pm + 1);
    if (miss) { load_rs(ssq, row0, fq, rs);
        if (wc == 0 && fq == 0) {
#pragma unroll
            for (int ai = 0; ai < 2; ++ai)
#pragma unroll
                for (int m = 0; m < 4; ++m) rsbuf[ai * HALF + wr * 64 + m * 16 + fr] = rs[ai][m]; }
    } else {
#pragma unroll
        for (int ai = 0; ai < 2; ++ai)
#pragma unroll
            for (int m = 0; m < 4; ++m) rs[ai][m] = rsbuf[ai * HALF + wr * 64 + m * 16 + fr];
    }
    return miss;
}
struct EpiProj {
    static constexpr bool PERM = true, AFTER_DRAIN = false;
    bf16_t* O; int ldc; const float* ssq; int pn_prod; PG8_LAS float* xch;
    __device__ __forceinline__ void operator()(const f32x4 (&acc)[2][2][4][2], const Unit& u, int wr, int wc, int fr, int fq) const {
        const int row0 = u.pm * BM + wr * 64 + fr;
        float rs[2][4]; const bool miss = get_rs(xch, ssq, u.pm, row0, wr, wc, fr, fq, rs);
        if (u.pn < pn_prod) {
            const int col0 = u.pn * BM + wc * 32 + 8 * fq;
#pragma unroll
            for (int ai = 0; ai < 2; ++ai)
#pragma unroll
                for (int m = 0; m < 4; ++m) { bf16_t* rowp = O + (size_t)(row0 + ai * HALF + m * 16) * ldc + col0; const float s = rs[ai][m];
#pragma unroll
                    for (int bj = 0; bj < 2; ++bj) { const f32x4 v0 = acc[ai][bj][m][0] * s, v1 = acc[ai][bj][m][1] * s;
                        u32x4 w; w.x = cvt_pk_bf16(v0[0], v0[1]); w.y = cvt_pk_bf16(v0[2], v0[3]); w.z = cvt_pk_bf16(v1[0], v1[1]); w.w = cvt_pk_bf16(v1[2], v1[3]);
                        *(u32x4*)(rowp + bj * HALF) = w; } }
        } else {
            const int col0 = pn_prod * BM + (u.pn - pn_prod) * HALF + wc * 32 + 8 * fq;
#pragma unroll
            for (int ai = 0; ai < 2; ++ai)
#pragma unroll
                for (int m = 0; m < 4; ++m) { const float s2 = rs[ai][m] * rs[ai][m];
                    const f32x4 v0 = acc[ai][0][m][0] * acc[ai][1][m][0] * s2, v1 = acc[ai][0][m][1] * acc[ai][1][m][1] * s2;
                    u32x4 w; w.x = cvt_pk_bf16(v0[0], v0[1]); w.y = cvt_pk_bf16(v0[2], v0[3]); w.z = cvt_pk_bf16(v1[0], v1[1]); w.w = cvt_pk_bf16(v1[2], v1[3]);
                    *(u32x4*)(O + (size_t)(row0 + ai * HALF + m * 16) * ldc + col0) = w; }
        }
        if (miss) { asm volatile("s_waitcnt lgkmcnt(0)" ::: "memory"); __builtin_amdgcn_s_barrier(); asm volatile("" ::: "memory");
            if (wr == 0 && wc == 0 && fr == 0 && fq == 0) *(volatile PG8_LAS int*)(xch + 1536) = u.pm + 1; }
    }
};
struct EpiRes {
    static constexpr bool PERM = true, AFTER_DRAIN = false;
    bf16_t* hb; float* ssq_out;
    __device__ __forceinline__ void operator()(const f32x4 (&acc)[2][2][4][2], const Unit& u, int wr, int wc, int fr, int fq) const {
        const int row0 = u.pm * BM + wr * 64 + fr, col0 = u.pn * BM + wc * 32 + 8 * fq;
#pragma unroll
        for (int ai = 0; ai < 2; ++ai)
#pragma unroll
            for (int m = 0; m < 4; ++m) { const int r = row0 + ai * HALF + m * 16; bf16_t* rowp = hb + (size_t)r * 1024 + col0; float s = 0.f;
                u32x4 bq[2];
#pragma unroll
                for (int bj = 0; bj < 2; ++bj) bq[bj] = *(const u32x4*)(rowp + bj * HALF);
#pragma unroll
                for (int bj = 0; bj < 2; ++bj) { const u32x4 b = bq[bj]; const f32x4 a0 = acc[ai][bj][m][0], a1 = acc[ai][bj][m][1];
                    const float o0 = __builtin_bit_cast(float, b.x << 16) + a0[0], o1 = __builtin_bit_cast(float, b.x & 0xffff0000u) + a0[1], o2 = __builtin_bit_cast(float, b.y << 16) + a0[2], o3 = __builtin_bit_cast(float, b.y & 0xffff0000u) + a0[3];
                    const float o4 = __builtin_bit_cast(float, b.z << 16) + a1[0], o5 = __builtin_bit_cast(float, b.z & 0xffff0000u) + a1[1], o6 = __builtin_bit_cast(float, b.w << 16) + a1[2], o7 = __builtin_bit_cast(float, b.w & 0xffff0000u) + a1[3];
                    s += ((o0 * o0 + o1 * o1) + (o2 * o2 + o3 * o3)) + ((o4 * o4 + o5 * o5) + (o6 * o6 + o7 * o7));
                    u32x4 w; w.x = cvt_pk_bf16(o0, o1); w.y = cvt_pk_bf16(o2, o3); w.z = cvt_pk_bf16(o4, o5); w.w = cvt_pk_bf16(o6, o7);
                    *(u32x4*)(rowp + bj * HALF) = w; }
                s += __shfl_xor(s, 16); s += __shfl_xor(s, 32);
                if (fq == 0) ssq_out[(size_t)r * 16 + u.pn * 4 + wc] = s; }
    }
};
struct EpiUG {
    static constexpr bool PERM = true, AFTER_DRAIN = false;
    bf16_t* act; const float* ssq; const float* cw; const float* cb; float* fixb; PG8_LAS float* xch;
    __device__ __forceinline__ void operator()(f32x4 (&acc)[2][2][4][2], const Unit& u, int wr, int wc, int fr, int fq) const {
        const int row0 = u.pm * BM + wr * 64 + fr, lcol = wc * 32 + 8 * fq, fcol = u.pn * HALF + lcol;
        PG8_LAS float* wts = xch + 768;
        const int tid_e = (wr * 4 + wc) * 64 + fq * 16 + fr;
        const float wv = (tid_e < 384) ? cw[(tid_e >> 7) * 3072 + u.pn * HALF + (tid_e & 127)] : cb[u.pn * HALF + (tid_e & 127)];
        float rs[2][4]; const bool miss = get_rs(xch, ssq, u.pm, row0, wr, wc, fr, fq, rs);
#pragma unroll
        for (int ai = 0; ai < 2; ++ai)
#pragma unroll
            for (int m = 0; m < 4; ++m)
#pragma unroll
                for (int bj = 0; bj < 2; ++bj)
#pragma unroll
                    for (int n = 0; n < 2; ++n) acc[ai][bj][m][n] = acc[ai][bj][m][n] * rs[ai][m];
        if (fr >= 14) {
#pragma unroll
            for (int ai = 0; ai < 2; ++ai) { const int q = 2 * ai + wr;
                if (q < 3) {
#pragma unroll
                    for (int n = 0; n < 2; ++n) *(PG8_LAS f32x4*)(xch + (q * 2 + (fr - 14)) * HALF + lcol + 4 * n) = acc[ai][0][3][n];
                } else {
#pragma unroll
                    for (int n = 0; n < 2; ++n) *(f32x4*)(fixb + ((size_t)u.pm * 6 + 4 + (fr - 14)) * 3072 + fcol + 4 * n) = acc[ai][0][3][n];
                } }
        }
        if (wr == 0 && fr < 2) {
#pragma unroll
            for (int n = 0; n < 2; ++n) { *(f32x4*)(fixb + ((size_t)u.pm * 6 + fr) * 3072 + fcol + 4 * n) = acc[0][0][0][n];
                                          *(f32x4*)(fixb + ((size_t)u.pm * 6 + 2 + fr) * 3072 + fcol + 4 * n) = acc[0][1][0][n]; }
        }
        wts[tid_e] = wv;
        asm volatile("s_waitcnt lgkmcnt(0)" ::: "memory"); __builtin_amdgcn_s_barrier(); asm volatile("" ::: "memory");
        if (miss && tid_e == 0) *(volatile PG8_LAS int*)(xch + 1536) = u.pm + 1;
        typedef unsigned u32x2v __attribute__((ext_vector_type(2)));
        u32x2v wlo[2][4];
#pragma unroll
        for (int n = 0; n < 2; ++n) {
            const f32x4 w0 = *(const PG8_LAS f32x4*)(wts + lcol + 4 * n), w1 = *(const PG8_LAS f32x4*)(wts + 128 + lcol + 4 * n), w2 = *(const PG8_LAS f32x4*)(wts + 256 + lcol + 4 * n), bb = *(const PG8_LAS f32x4*)(wts + 384 + lcol + 4 * n);
#pragma unroll
            for (int ai = 0; ai < 2; ++ai) { const int q = 2 * ai + wr;
                f32x4 B0 = (f32x4){0.f, 0.f, 0.f, 0.f}, B1 = B0;
                if (q > 0) { B0 = *(const PG8_LAS f32x4*)(xch + ((q - 1) * 2 + 0) * HALF + lcol + 4 * n); B1 = *(const PG8_LAS f32x4*)(xch + ((q - 1) * 2 + 1) * HALF + lcol + 4 * n); }
                f32x4 R1p = B1, R2p;
#pragma unroll
                for (int e = 0; e < 4; ++e) R2p[e] = (fr == 1) ? B1[e] : B0[e];
#pragma unroll
                for (int m = 0; m < 4; ++m) { const f32x4 cur = acc[ai][0][m][n], gt = acc[ai][1][m][n]; f32x4 R1, R2, p1, p2;
#pragma unroll
                    for (int e = 0; e < 4; ++e) { R1[e] = dpp_ror1(cur[e]); R2[e] = dpp_ror2(cur[e]); p1[e] = (fr >= 1) ? R1[e] : R1p[e]; p2[e] = (fr >= 2) ? R2[e] : R2p[e]; }
                    R1p = R1; R2p = R2;
                    const f32x2 va = (f32x2){w0[0], w0[1]} * (f32x2){p2[0], p2[1]} + (f32x2){w1[0], w1[1]} * (f32x2){p1[0], p1[1]} + (f32x2){w2[0], w2[1]} * (f32x2){cur[0], cur[1]} + (f32x2){bb[0], bb[1]};
                    const f32x2 vb = (f32x2){w0[2], w0[3]} * (f32x2){p2[2], p2[3]} + (f32x2){w1[2], w1[3]} * (f32x2){p1[2], p1[3]} + (f32x2){w2[2], w2[3]} * (f32x2){cur[2], cur[3]} + (f32x2){bb[2], bb[3]};
                    const f32x2 oa = gelu_tanh_pk(va) * (f32x2){gt[0], gt[1]}, ob = gelu_tanh_pk(vb) * (f32x2){gt[2], gt[3]};
                    u32x2v w; w.x = cvt_pk_bf16(oa.x, oa.y); w.y = cvt_pk_bf16(ob.x, ob.y);
                    if (n == 0) wlo[ai][m] = w;
                    else { u32x4 w4; w4.x = wlo[ai][m].x; w4.y = wlo[ai][m].y; w4.z = w.x; w4.w = w.y; *(u32x4*)(act + (size_t)(row0 + ai * HALF + m * 16) * 3072 + fcol) = w4; } } }
        }
    }
};

template <class Epi, class Sched, bool ALIGN_EPI = false, bool SP2 = false>
__device__ __forceinline__ void gemm_phase(PG8_LAS unsigned char* lds, const Gemm g, const Sched& S, const Epi& E) {
    int tid_o = threadIdx.x; asm volatile("" : "+v"(tid_o));
    const int tid = tid_o, wid = __builtin_amdgcn_readfirstlane(tid >> 6), lane = tid & 63, wr = wid >> 2, wc = wid & 3, fr = lane & 15, fq = lane >> 4;
    const int K = g.K, nt = K / BK;
    unsigned voffA[2], voffB[2];
#pragma unroll
    for (int i = 0; i < 2; ++i) { int R, C; stage_rc(tid * 16 + i * 8192, R, C); const int Rb = Epi::PERM ? ((R & ~31) + perm32(R & 31)) : R;
        voffA[i] = (unsigned)(R * K + C) * 2u; voffB[i] = (unsigned)(Rb * K + C) * 2u; }
    const size_t kstep = (size_t)(BK * 2);
    const size_t hstep = (size_t)HALF * K * 2;
    const size_t tstep = 2 * hstep;
    const unsigned ldsw = (unsigned)wid * 1024u;
    const int aoff = lds_byte(wr * 64 + fr, fq * 8), boff = lds_byte(wc * 32 + fr, fq * 8);
#define PG8_SA(b, h) (((b) * 2 + (h)) * HTB)
#define PG8_SB(b, h) ((4 + (b) * 2 + (h)) * HTB)
#define PG8_STAGE(bufoff, gbase, voff) do { _Pragma("unroll") for (int _i = 0; _i < 2; ++_i) \
        __builtin_amdgcn_global_load_lds((const unsigned*)((const char*)(gbase) + (voff)[_i]), (PG8_LAS unsigned*)(lds + (bufoff) + ldsw + _i * 8192), 16, 0, 0); } while (0)
#define PG8_LDA(dst, b, h) do { _Pragma("unroll") for (int m = 0; m < 4; ++m) _Pragma("unroll") for (int k = 0; k < 2; ++k) dst[m][k] = *(const PG8_LAS bf16x8*)(lds + PG8_SA(b, h) + aoff + m * 2048 + k * 1024); } while (0)
#define PG8_LDB(dst, b, h) do { _Pragma("unroll") for (int n = 0; n < 2; ++n) _Pragma("unroll") for (int k = 0; k < 2; ++k) dst[n][k] = *(const PG8_LAS bf16x8*)(lds + PG8_SB(b, h) + boff + n * 2048 + k * 1024); } while (0)
#define PG8_MMA(ai, bj, At, Bt) do { __builtin_amdgcn_s_setprio(1); _Pragma("unroll") for (int m = 0; m < 4; ++m) _Pragma("unroll") for (int n = 0; n < 2; ++n) _Pragma("unroll") for (int k = 0; k < 2; ++k) \
        acc[ai][bj][m][n] = __builtin_amdgcn_mfma_f32_16x16x32_bf16(Bt[n][k], At[m][k], acc[ai][bj][m][n], 0, 0, 0); __builtin_amdgcn_s_setprio(0); } while (0)
#define PG8_WAIT_V(n) asm volatile("s_waitcnt vmcnt(" #n ")" ::: "memory")
#define PG8_WAIT_L(n) asm volatile("s_waitcnt lgkmcnt(" #n ")" ::: "memory")
#define PG8_BAR __builtin_amdgcn_s_barrier()
#define PG8_SCHED __builtin_amdgcn_sched_barrier(0)
    Unit cur, nxt; int ui = 0;
    if (!S.next(0, cur)) return;
    f32x4 acc[2][2][4][2];
#pragma unroll
    for (int a = 0; a < 2; ++a)
#pragma unroll
        for (int b = 0; b < 2; ++b)
#pragma unroll
            for (int m = 0; m < 4; ++m)
#pragma unroll
                for (int n = 0; n < 2; ++n) acc[a][b][m][n] = (f32x4){0.f, 0.f, 0.f, 0.f};
    bf16x8 At[4][2], B0[2][2], B1[2][2];
    const char* cA = (const char*)g.A + (size_t)cur.pm * tstep; const char* cB = (const char*)g.Bt + (size_t)cur.pn * tstep;
    S.a_ready(cur);
    if constexpr (SP2) {
        PG8_STAGE(PG8_SB(0, 0), cB, voffB); PG8_STAGE(PG8_SB(0, 1), cB + hstep, voffB); PG8_STAGE(PG8_SA(0, 0), cA, voffA); PG8_STAGE(PG8_SA(0, 1), cA + hstep, voffA);
        if (wr == 1) PG8_BAR;
        PG8_WAIT_V(2); PG8_BAR;
        PG8_STAGE(PG8_SB(1, 0), cB + kstep, voffB); PG8_STAGE(PG8_SA(1, 0), cA + kstep, voffA); PG8_STAGE(PG8_SB(1, 1), cB + hstep + kstep, voffB);
        PG8_WAIT_V(6); PG8_BAR;
    } else {
        PG8_STAGE(PG8_SB(0, 0), cB, voffB); PG8_STAGE(PG8_SA(0, 0), cA, voffA); PG8_STAGE(PG8_SB(0, 1), cB + hstep, voffB); PG8_STAGE(PG8_SA(0, 1), cA + hstep, voffA);
        if (wr == 1) PG8_BAR;
        PG8_WAIT_V(4); PG8_BAR;
        PG8_STAGE(PG8_SB(1, 0), cB + kstep, voffB); PG8_STAGE(PG8_SA(1, 0), cA + kstep, voffA); PG8_STAGE(PG8_SB(1, 1), cB + hstep + kstep, voffB);
        PG8_WAIT_V(6); PG8_BAR;
    }
    for (;;) {
        const bool has_next = S.next(ui + 1, nxt);
        const char* nA = has_next ? (const char*)g.A + (size_t)nxt.pm * tstep : cA; const char* nB = has_next ? (const char*)g.Bt + (size_t)nxt.pn * tstep : cB;
        for (int t = 0; t < nt; t += 2) {
            const bool last = (t == nt - 2);
            const char* a1 = cA + (size_t)(t + 1) * kstep;
            const char* a2 = last ? nA : cA + (size_t)(t + 2) * kstep; const char* b2 = last ? nB : cB + (size_t)(t + 2) * kstep;
            const char* a3 = a2 + kstep; const char* b3 = b2 + kstep;
            if (last && has_next) S.a_ready(nxt);
            if constexpr (SP2) {
            PG8_LDB(B0, 0, 0); PG8_LDB(B1, 0, 1); PG8_SCHED; PG8_LDA(At, 0, 0); PG8_STAGE(PG8_SA(1, 1), a1 + hstep, voffA);
            PG8_WAIT_V(8); PG8_WAIT_L(0); PG8_BAR; PG8_MMA(0, 0, At, B0); PG8_MMA(0, 1, At, B1); PG8_BAR; PG8_SCHED;
            PG8_LDA(At, 0, 1); PG8_STAGE(PG8_SB(0, 0), b2, voffB); PG8_STAGE(PG8_SB(0, 1), b2 + hstep, voffB); PG8_STAGE(PG8_SA(0, 0), a2, voffA);
            PG8_WAIT_V(8); PG8_WAIT_L(0); PG8_BAR; PG8_MMA(1, 0, At, B0); PG8_MMA(1, 1, At, B1); PG8_BAR; PG8_SCHED;
            PG8_LDB(B0, 1, 0); PG8_LDB(B1, 1, 1); PG8_SCHED; PG8_LDA(At, 1, 0); PG8_STAGE(PG8_SA(0, 1), a2 + hstep, voffA);
            PG8_WAIT_V(8); PG8_WAIT_L(0); PG8_BAR; PG8_MMA(0, 0, At, B0); PG8_MMA(0, 1, At, B1); PG8_BAR; PG8_SCHED;
            PG8_LDA(At, 1, 1); PG8_STAGE(PG8_SB(1, 0), b3, voffB); PG8_STAGE(PG8_SB(1, 1), b3 + hstep, voffB); PG8_STAGE(PG8_SA(1, 0), a3, voffA);
            PG8_WAIT_V(8); PG8_WAIT_L(0); PG8_BAR; PG8_MMA(1, 0, At, B0); PG8_MMA(1, 1, At, B1); PG8_BAR; PG8_SCHED;
            } else {
            PG8_LDB(B0, 0, 0); PG8_SCHED; PG8_LDA(At, 0, 0); PG8_STAGE(PG8_SA(1, 1), a1 + hstep, voffA);
            PG8_WAIT_L(8); PG8_BAR; PG8_WAIT_L(0); PG8_MMA(0, 0, At, B0); PG8_BAR; PG8_SCHED;
            PG8_LDB(B1, 0, 1); PG8_STAGE(PG8_SB(0, 0), b2, voffB);
            PG8_BAR; PG8_WAIT_L(0); PG8_MMA(0, 1, At, B1); PG8_BAR;
            PG8_LDA(At, 0, 1); PG8_STAGE(PG8_SA(0, 0), a2, voffA);
            PG8_BAR; PG8_WAIT_L(0); PG8_MMA(1, 0, At, B0); PG8_BAR; PG8_SCHED;
            PG8_STAGE(PG8_SB(0, 1), b2 + hstep, voffB);
            PG8_WAIT_V(6); PG8_BAR; PG8_MMA(1, 1, At, B1); PG8_BAR;
            PG8_LDB(B0, 1, 0); PG8_SCHED; PG8_LDA(At, 1, 0); PG8_STAGE(PG8_SA(0, 1), a2 + hstep, voffA);
            PG8_WAIT_L(8); PG8_BAR; PG8_WAIT_L(0); PG8_MMA(0, 0, At, B0); PG8_BAR; PG8_SCHED;
            PG8_LDB(B1, 1, 1); PG8_STAGE(PG8_SB(1, 0), b3, voffB);
            PG8_BAR; PG8_WAIT_L(0); PG8_MMA(0, 1, At, B1); PG8_BAR;
            PG8_LDA(At, 1, 1); PG8_STAGE(PG8_SA(1, 0), a3, voffA);
            PG8_BAR; PG8_WAIT_L(0); PG8_MMA(1, 0, At, B0); PG8_BAR; PG8_SCHED;
            PG8_STAGE(PG8_SB(1, 1), b3 + hstep, voffB);
            PG8_WAIT_V(6); PG8_BAR; PG8_MMA(1, 1, At, B1); PG8_BAR;
            }
        }
        if constexpr (ALIGN_EPI) { if (wr == 0) PG8_BAR; }
        if constexpr (!Epi::AFTER_DRAIN) { E(acc, cur, wr, wc, fr, fq); S.done(cur); }
        if (!has_next) break;
#pragma unroll
        for (int a = 0; a < 2; ++a)
#pragma unroll
            for (int b = 0; b < 2; ++b)
#pragma unroll
                for (int m = 0; m < 4; ++m)
#pragma unroll
                    for (int n = 0; n < 2; ++n) acc[a][b][m][n] = (f32x4){0.f, 0.f, 0.f, 0.f};
        cur = nxt; cA = nA; cB = nB; ++ui;
        if constexpr (ALIGN_EPI) { if (wr == 1) PG8_BAR; }
    }
    PG8_WAIT_V(0);
    if constexpr (!ALIGN_EPI) { if (wr == 0) PG8_BAR; }
    PG8_BAR;
    if constexpr (Epi::AFTER_DRAIN) { E.fused(acc, cur, wr, wc, fr, fq, lds, wid, lane); S.done(cur); }
#undef PG8_SA
#undef PG8_SB
#undef PG8_STAGE
#undef PG8_LDA
#undef PG8_LDB
#undef PG8_MMA
#undef PG8_WAIT_V
#undef PG8_WAIT_L
#undef PG8_BAR
#undef PG8_SCHED
}
}
#include <hip/hip_cooperative_groups.h>
#ifndef PROBE_DUP
#define PROBE_DUP 0
#endif
#define REP(bit) for (int rep_ = 0; rep_ < ((PROBE_DUP & (bit)) ? 2 : 1); ++rep_)
#ifndef MK_N_LAUNCHES
#define MK_N_LAUNCHES 1
#endif

constexpr int NWAVES = 8;
constexpr int DEPTH = 4, BATCH = 16, SEQ = 2048, D = 1024, INC = 2560, FF = 3072, LW = 512;
constexpr int PW = 2048;
constexpr int M = BATCH * SEQ;
constexpr int NG = 4, GX = 8 / NG;
constexpr int BH = BATCH / NG, MH = M / NG;
constexpr int CH = 128, NCH = SEQ / CH;
constexpr size_t MiB = 1u << 20;
constexpr size_t WS_CTL = 0, CTL_ZERO_BYTES = 64 * 1024;
constexpr size_t WS_WA = 2 * MiB, WS_WX = WS_WA + 512 * 1024;
constexpr size_t WS_SSQ1 = 3 * MiB, WS_SSQ2 = 5 * MiB;
constexpr size_t WS_EH = 7 * MiB, WS_EP = 8 * MiB;
constexpr size_t WS_FIX = 9 * MiB;
constexpr size_t WS_WIN = 20 * MiB, WS_WOUT = 40 * MiB, WS_WUG = 48 * MiB, WS_WDN = 96 * MiB;
constexpr size_t WS_HB = 120 * MiB, WS_Y = 184 * MiB, WS_R = 248 * MiB, R_HALF = (192 / NG) * MiB;
constexpr size_t R_HLOC = (128 / NG) * MiB, R_PCUM = (160 / NG) * MiB, WS_END = WS_R + NG * R_HALF;
static_assert(WS_FIX + (size_t)(M / 256) * 6 * FF * 4 <= WS_WIN && (size_t)MH * PW * 2 <= R_HLOC && R_HLOC + (size_t)MH * LW * 2 <= R_PCUM && R_PCUM + (size_t)MH * LW * 2 <= R_HALF && (size_t)MH * FF * 2 <= R_HALF, "ws map");
constexpr int CW_BAR = 1024;
constexpr int CW_FLAG = 15360;
constexpr int RING_BYTES = 131072, XCH_OFF = RING_BYTES, MISC_OFF = XCH_OFF + 8192, LDS_BYTES = 147456;

#define GAS __attribute__((address_space(1)))
#define LAS __attribute__((address_space(3)))
typedef unsigned short bf16;
typedef unsigned v4u __attribute__((ext_vector_type(4)));
typedef float f32x4 __attribute__((ext_vector_type(4)));
typedef short bf16x8 __attribute__((ext_vector_type(8)));
typedef GAS unsigned gu32;
typedef GAS unsigned long long gu64;
#define RLX_AGENT __ATOMIC_RELAXED, __HIP_MEMORY_SCOPE_AGENT
#define LDS_WAIT() asm volatile("s_waitcnt lgkmcnt(0)" ::: "memory")
#define VM_WAIT() asm volatile("s_waitcnt vmcnt(0)" ::: "memory")
__device__ __forceinline__ unsigned long long rt() { return __builtin_amdgcn_s_memrealtime(); }
__device__ __forceinline__ unsigned f2bf(float f) { unsigned u = __builtin_bit_cast(unsigned, f); return (u + 0x7fffu + ((u >> 16) & 1u)) >> 16; }
__device__ __forceinline__ unsigned pk2(float lo, float hi) { return f2bf(lo) | (f2bf(hi) << 16); }

#define XB_TMO      128
#define XB_XCNT(j)  (256  + 64 * (j))
#define XB_XSUB(j)  (1280 + 64 * (j))
#define XB_XGEN(j)  (2304 + 64 * (j))
#define XB_TOP      3328
#define XB_TOPGEN   3392
#define XCD_BAR_WORDS 3456
#define XB_SPIN_CAP (1u << 18)

__device__ __forceinline__ unsigned xb_ld(unsigned* p)              { return __hip_atomic_load(p, __ATOMIC_RELAXED, __HIP_MEMORY_SCOPE_AGENT); }
__device__ __forceinline__ unsigned xb_add(unsigned* p, unsigned v) { return __hip_atomic_fetch_add(p, v, __ATOMIC_RELAXED, __HIP_MEMORY_SCOPE_AGENT); }
__device__ __forceinline__ unsigned xb_xcc_id() { return (unsigned)__builtin_amdgcn_s_getreg((3 << 11) | 20) & 0xFu; }
#define XB_SPIN(cond, bar) do { unsigned _sp = 0; while (cond) { __builtin_amdgcn_s_sleep(1); \
    if ((++_sp & 255u) == 0u) { if (xb_ld(&(bar)[XB_TMO])) break; if (_sp > XB_SPIN_CAP) { atomicAdd(&(bar)[XB_TMO], 1u); break; } } } } while (0)

struct XcdBarrier {
    unsigned* bar; unsigned x;
    volatile LAS unsigned* st;
    unsigned expect;
};

__device__ __forceinline__ XcdBarrier xcd_barrier_post(unsigned* bar, volatile LAS unsigned* st, unsigned expect) {
    XcdBarrier b; b.bar = bar; b.x = xb_xcc_id(); b.st = st; b.expect = expect;
    if (threadIdx.x == 0) (void)xb_add(&bar[XB_XCNT(b.x)], 1u);
    return b;
}
__device__ __forceinline__ void xcd_barrier_complete(unsigned* bar, unsigned x, unsigned& nloc, unsigned& nx, unsigned G) {
    unsigned sum, cnt, mine, sp = 0u;
    for (;;) {
        sum = 0u; cnt = 0u; mine = 0u;
#pragma unroll
        for (unsigned j = 0; j < 16; ++j) { const unsigned c = xb_ld(&bar[XB_XCNT(j)]); sum += c; cnt += (c > 0u) ? 1u : 0u; mine = (j == x) ? c : mine; }
        if (sum == G) break;
        __builtin_amdgcn_s_sleep(1);
        if ((++sp & 255u) == 0u) { if (xb_ld(&bar[XB_TMO])) break; if (sp > XB_SPIN_CAP) { atomicAdd(&bar[XB_TMO], 1u); break; } }
    }
    nloc = mine > 0u ? mine : 1u; nx = cnt > 0u ? cnt : 1u;
}

__device__ __forceinline__ void xcd_barrier(const XcdBarrier& b) {
    asm volatile("s_waitcnt vmcnt(0)" ::: "memory");
    __syncthreads();
    if (threadIdx.x == 0) {
        unsigned* bar = b.bar;
        __builtin_amdgcn_s_waitcnt(0);
        unsigned nloc = b.st[0], nx = b.st[1];
        if (nloc == 0u) { xcd_barrier_complete(bar, b.x, nloc, nx, b.expect); b.st[0] = nloc; b.st[1] = nx; }
        const unsigned old = xb_add(&bar[XB_XSUB(b.x)], 1u);
        const unsigned gen = old / nloc;
        if (old + 1u == (gen + 1u) * nloc) {
            __builtin_amdgcn_fence(__ATOMIC_RELEASE, "agent");
            asm volatile("s_waitcnt vmcnt(0)" ::: "memory");
            const unsigned og = xb_add(&bar[XB_TOP], 1u);
            const unsigned tg = og / nx;
            if (og + 1u == (tg + 1u) * nx) xb_add(&bar[XB_TOPGEN], 1u);
            else XB_SPIN(xb_ld(&bar[XB_TOPGEN]) == tg, bar);
            __builtin_amdgcn_fence(__ATOMIC_ACQUIRE, "agent");
            xb_add(&bar[XB_XGEN(b.x)], 1u);
            asm volatile("s_waitcnt vmcnt(0)" ::: "memory");
        } else {
            XB_SPIN(xb_ld(&bar[XB_XGEN(b.x)]) == gen, bar);
            __builtin_amdgcn_fence(__ATOMIC_ACQUIRE, "agent");
            asm volatile("s_waitcnt vmcnt(0)" ::: "memory");
        }
    }
    __syncthreads();
}

struct Args {
    const float* x; const float* norm1_g; const float* w_in; const float* lru_conv_w; const float* lru_conv_b; const float* lru_w_a; const float* lru_b_a;
    const float* lru_w_x; const float* lru_b_x; const float* lru_lambda; const float* sc_conv_w; const float* lru_out_g; const float* sc_out_g; const float* w_out;
    const float* norm2_g; const float* mlp_w_up; const float* mlp_w_gate; const float* mlp_conv_w; const float* mlp_conv_b; const float* mlp_w_down; const float* final_g;
    float* out; unsigned char* ws; int ph_lo, ph_hi;
};
__device__ __forceinline__ float wave_sum(float v) {
#pragma unroll
    for (int o = 1; o < 64; o <<= 1) v += __shfl_xor(v, o);
    return v;
}
__device__ __forceinline__ float bf2f(unsigned short b) { return __builtin_bit_cast(float, (unsigned)b << 16); }
__device__ __forceinline__ float bflo(unsigned w) { return __builtin_bit_cast(float, w << 16); }
__device__ __forceinline__ float bfhi(unsigned w) { return __builtin_bit_cast(float, w & 0xffff0000u); }
__device__ __forceinline__ void unpack8(v4u w, float (&f)[8]) { f[0] = bflo(w.x); f[1] = bfhi(w.x); f[2] = bflo(w.y); f[3] = bfhi(w.y); f[4] = bflo(w.z); f[5] = bfhi(w.z); f[6] = bflo(w.w); f[7] = bfhi(w.w); }
__device__ __forceinline__ v4u pack8(const float (&f)[8]) { v4u w; w.x = pg8::cvt_pk_bf16(f[0], f[1]); w.y = pg8::cvt_pk_bf16(f[2], f[3]); w.z = pg8::cvt_pk_bf16(f[4], f[5]); w.w = pg8::cvt_pk_bf16(f[6], f[7]); return w; }

__device__ __forceinline__ void p0_tile_load(const float* W, int N, int k0, int n0, const float* gain, LAS float* scr, int lane) {
    const int kq = lane >> 3, n4 = (lane & 7) * 4;
    f32x4 v[8];
#pragma unroll
    for (int i = 0; i < 8; ++i) v[i] = *(const GAS f32x4*)(W + (size_t)(k0 + kq + 8 * i) * N + n0 + n4);
#pragma unroll
    for (int i = 0; i < 8; ++i) { const int kk = kq + 8 * i; const float g = gain ? gain[k0 + kk] : 1.0f; LAS float* d = scr + kk * 33 + n4; d[0] = v[i].x * g; d[1] = v[i].y * g; d[2] = v[i].z * g; d[3] = v[i].w * g; }
    LDS_WAIT(); asm volatile("" ::: "memory");
}
__device__ __forceinline__ void p0_tile_store(bf16* WT, int K, int k0, int rbase, LAS float* scr, int lane) {
    const int c = lane & 7;
#pragma unroll
    for (int j = 0; j < 4; ++j) { const int n = (lane >> 3) + 8 * j; const LAS float* s = scr + (8 * c) * 33 + n;
        v4u o; o.x = pk2(s[0 * 33], s[1 * 33]); o.y = pk2(s[2 * 33], s[3 * 33]); o.z = pk2(s[4 * 33], s[5 * 33]); o.w = pk2(s[6 * 33], s[7 * 33]);
        *(GAS v4u*)(WT + (size_t)(rbase + n) * K + k0 + 8 * c) = o; }
    LDS_WAIT(); asm volatile("" ::: "memory");
}
__device__ __forceinline__ void p0_transpose_item(const float* W, int K, int N, bf16* WT, int row_off, const float* gain, LAS float* scr, int item, int lane) {
    const int nblk = N / 32, kb = item / nblk, nb = item % nblk, k0 = 64 * kb, n0 = 32 * nb;
    p0_tile_load(W, N, k0, n0, gain, scr, lane); p0_tile_store(WT, K, k0, row_off + n0, scr, lane);
}
__device__ __forceinline__ void p0_transpose_item_ug(const float* W, bf16* WT, int half, const float* gain, LAS float* scr, int item, int lane) {
    constexpr int K = D, N = FF;
    const int nblk = N / 32, kb = item / nblk, nb = item % nblk, k0 = 64 * kb, n0 = 32 * nb;
    p0_tile_load(W, N, k0, n0, gain, scr, lane); p0_tile_store(WT, K, k0, 256 * (n0 / 128) + (n0 % 128) + 128 * half, scr, lane);
}

__global__ void __launch_bounds__(NWAVES * 64, 2) mk_fwd(Args args) {
    extern __shared__ __attribute__((aligned(16))) unsigned char lds_raw[];
    LAS unsigned char* lds = (LAS unsigned char*)lds_raw;
    volatile LAS unsigned* MISC = (volatile LAS unsigned*)(lds + MISC_OFF);
    const int tid_k = threadIdx.x, lane_k = tid_k & 63, wave = __builtin_amdgcn_readfirstlane(tid_k >> 6);
    const int bx = blockIdx.x, half = (bx & 7) / GX;
    const int G = gridDim.x / NG;
    const int chh = (bx >> 3) * GX + (bx & (GX - 1));
    const int vcu = (bx & (GX - 1)) * (G / GX) + (bx >> 3);
    const int gw = vcu * NWAVES + wave, NGW = G * NWAVES;
    unsigned char* ws = args.ws;
    for (int u = tid_k; u < (LDS_BYTES - XCH_OFF) / 4; u += NWAVES * 64) ((LAS unsigned*)(lds + XCH_OFF))[u] = 0u;
    __syncthreads();
    XcdBarrier bar = xcd_barrier_post((unsigned*)(ws + WS_CTL) + CW_BAR + half * XCD_BAR_WORDS, MISC + 8, (unsigned)G);
    unsigned* xflag = (unsigned*)(ws + WS_CTL) + CW_FLAG;
    bf16* Wa_t = (bf16*)(ws + WS_WA); bf16* Wx_t = (bf16*)(ws + WS_WX);
    float* ssq1 = (float*)(ws + WS_SSQ1) + (size_t)half * MH * 16; float* ssq2 = (float*)(ws + WS_SSQ2) + (size_t)half * MH * 16;
    float* Eh = (float*)(ws + WS_EH) + (size_t)half * BH * NCH * LW; float* EP = (float*)(ws + WS_EP) + (size_t)half * BH * NCH * LW; float* fixb = (float*)(ws + WS_FIX) + (size_t)half * (MH / 256) * 6 * FF;
    bf16* Win_t = (bf16*)(ws + WS_WIN); bf16* Wout_t = (bf16*)(ws + WS_WOUT); bf16* Wug_t = (bf16*)(ws + WS_WUG); bf16* Wdn_t = (bf16*)(ws + WS_WDN);
    unsigned char* rh = ws + WS_R + (size_t)half * R_HALF;
    bf16* hb = (bf16*)(ws + WS_HB) + (size_t)half * MH * D; bf16* yb = (bf16*)(ws + WS_Y) + (size_t)half * MH * D; bf16* proj = (bf16*)rh; bf16* act = (bf16*)rh;
    bf16* hloc = (bf16*)(rh + R_HLOC); bf16* pcum = (bf16*)(rh + R_PCUM);
    const float* xin = args.x + (size_t)half * MH * D; float* outp = args.out + (size_t)half * MH * D;
    const int lo = args.ph_lo, hi = args.ph_hi;
    int ph = 0;
#define RUN(k) (lo <= (k) && (k) < hi)
#define SEAM(k) do { if (RUN(k) && RUN((k) + 1)) xcd_barrier(bar); } while (0)

    if (RUN(ph)) REP(1) {
        int lane; asm volatile("v_mbcnt_lo_u32_b32 %0, -1, 0\n\tv_mbcnt_hi_u32_b32 %0, -1, %0" : "=v"(lane));
        LAS float* scr = (LAS float*)(lds + wave * 16384);
        constexpr int I_IN = (D / 64) * (INC / 32), I_OUT = (D / 64) * (D / 32), I_UP = (D / 64) * (FF / 32), I_DN = (FF / 64) * (D / 32), I_G = 2;
        constexpr int PER_LAYER = I_IN + I_OUT + 2 * I_UP + I_DN;
        const int TB0 = 0, TB1 = PER_LAYER, TB2 = PER_LAYER + (DEPTH - 1) * PER_LAYER * 5 / 18, TB3 = PER_LAYER + (DEPTH - 1) * PER_LAYER * 11 / 18, TB4 = DEPTH * PER_LAYER;
        const int tlo = half == 0 ? TB0 : half == 1 ? TB1 : half == 2 ? TB2 : TB3, thi = half == 0 ? TB1 : half == 1 ? TB2 : half == 2 ? TB3 : TB4;
        const int nmine = (thi - tlo) + (half == 0 ? DEPTH * 8 * 2 * I_G : 0);
        for (int it = gw; it < nmine; it += NGW) {
            int l, r;
            if (it >= thi - tlo) { r = it - (thi - tlo); l = r / (8 * 2 * I_G); r %= 8 * 2 * I_G;
                const int hd = r / (2 * I_G), mat = (r / I_G) & 1, sub = r % I_G; const size_t o = ((size_t)l * 8 + hd) * 64 * 64;
                p0_transpose_item((mat ? args.lru_w_x : args.lru_w_a) + o, 64, 64, (mat ? Wx_t : Wa_t) + o, 0, nullptr, scr, sub, lane); continue; }
            l = (it + tlo) / PER_LAYER; r = (it + tlo) % PER_LAYER;
            if (r < I_IN) { const int kb = r / (INC / 32), n0 = 32 * (r % (INC / 32));
                int rb = n0; if (n0 >= 2048) { const int f = n0 - 2048; rb = 1536 + 256 * (f / 128) + 128 + (f % 128); } else if (n0 >= 1536) { const int f = n0 - 1536; rb = 1536 + 256 * (f / 128) + (f % 128); }
                p0_tile_load(args.w_in + (size_t)l * D * INC, INC, 64 * kb, n0, args.norm1_g + l * D, scr, lane); p0_tile_store(Win_t + (size_t)l * INC * D, D, 64 * kb, rb, scr, lane); continue; } r -= I_IN;
            if (r < I_OUT) { const int kb = r / (D / 32); const float* g = (kb < 8) ? args.lru_out_g + l * LW + 0 : args.sc_out_g + l * LW - LW;
                p0_transpose_item(args.w_out + (size_t)l * D * D, D, D, Wout_t + (size_t)l * D * D, 0, g, scr, r, lane); continue; } r -= I_OUT;
            if (r < I_UP) { p0_transpose_item_ug(args.mlp_w_up + (size_t)l * D * FF, Wug_t + (size_t)l * 2 * FF * D, 0, args.norm2_g + l * D, scr, r, lane); continue; } r -= I_UP;
            if (r < I_UP) { p0_transpose_item_ug(args.mlp_w_gate + (size_t)l * D * FF, Wug_t + (size_t)l * 2 * FF * D, 1, args.norm2_g + l * D, scr, r, lane); continue; } r -= I_UP;
            p0_transpose_item(args.mlp_w_down + (size_t)l * FF * D, FF, D, Wdn_t + (size_t)l * D * FF, 0, nullptr, scr, r, lane);
        }
        for (int m = gw; m < MH; m += NGW) {
            const GAS f32x4* xr = (const GAS f32x4*)(xin + (size_t)m * D) + lane;
            f32x4 v[4]; float s = 0.f;
#pragma unroll
            for (int j = 0; j < 4; ++j) { v[j] = xr[64 * j]; s += (v[j].x * v[j].x + v[j].y * v[j].y) + (v[j].z * v[j].z + v[j].w * v[j].w); }
            s = wave_sum(s);
            GAS unsigned long long* o8 = (GAS unsigned long long*)(hb + (size_t)m * D) + lane;
#pragma unroll
            for (int j = 0; j < 4; ++j) o8[64 * j] = (unsigned long long)pg8::cvt_pk_bf16(v[j].x, v[j].y) | ((unsigned long long)pg8::cvt_pk_bf16(v[j].z, v[j].w) << 32);
            if (lane < 4) *(f32x4*)(ssq1 + (size_t)m * 16 + 4 * lane) = (f32x4){lane == 0 ? s : 0.f, 0.f, 0.f, 0.f};
        }
    }
    if (hi < 0) cooperative_groups::this_grid().sync();
    xcd_barrier(bar);
    if (vcu == 0 && tid_k == 0) __hip_atomic_store(xflag + 64 * half, 1u, __ATOMIC_RELEASE, __HIP_MEMORY_SCOPE_AGENT);
#define WAIT_HALF(h) do { if (tid_k == 0) { unsigned sp_ = 0; while (__hip_atomic_load(xflag + 64 * (h), __ATOMIC_RELAXED, __HIP_MEMORY_SCOPE_AGENT) == 0u && ++sp_ < (1u << 22)) __builtin_amdgcn_s_sleep(8); \
        __builtin_amdgcn_fence(__ATOMIC_ACQUIRE, "agent"); asm volatile("s_waitcnt vmcnt(0)" ::: "memory"); } __syncthreads(); } while (0)
    if (half != 0) WAIT_HALF(0);
    ++ph;

    for (int l = 0; l < DEPTH; ++l) {
        if (RUN(ph)) {
            if (l == 1) { for (int h2 = 1; h2 < NG; ++h2) if (h2 != half) WAIT_HALF(h2); }
            pg8::Gemm g{hb, Win_t + (size_t)l * INC * D, MH, INC, D}; pg8::StaticOrder S; S.init(MH, INC, G, chh, GX);
            pg8::EpiProj E{proj, PW, ssq1, 6, (LAS float*)(lds + XCH_OFF)};
            REP(2) pg8::gemm_phase<pg8::EpiProj, pg8::StaticOrder, true, true>(lds, g, S, E);
            if (tid_k == 0) *(volatile LAS int*)(lds + XCH_OFF + 1536 * 4) = 0;
        }
        SEAM(ph); ++ph;
        if (RUN(ph)) {
            int lane; asm volatile("v_mbcnt_lo_u32_b32 %0, -1, 0\n\tv_mbcnt_hi_u32_b32 %0, -1, %0" : "=v"(lane));
            const int fr = lane & 15, fq = lane >> 4, ch = 64 * wave + lane;
            LAS bf16* sA = (LAS bf16*)(lds + wave * 12288);
            LAS float* sR = (LAS float*)(lds + wave * 12288 + 2560);
            LAS float* sI = sR + 16 * 68;
            const float cw0 = args.lru_conv_w[(l * 4 + 0) * LW + ch], cw1 = args.lru_conv_w[(l * 4 + 1) * LW + ch], cw2 = args.lru_conv_w[(l * 4 + 2) * LW + ch], cw3 = args.lru_conv_w[(l * 4 + 3) * LW + ch];
            const float cbias = args.lru_conv_b[l * LW + ch], ba = args.lru_b_a[l * LW + ch], bx = args.lru_b_x[l * LW + ch];
            const float c2 = -8.0f * log1pf(__expf(-args.lru_lambda[l * LW + ch])) * 1.44269504089f;
            pg8::bf16x8 Ba[4][2], Bx[4][2];
#pragma unroll
            for (int nt = 0; nt < 4; ++nt)
#pragma unroll
                for (int ks = 0; ks < 2; ++ks) { const size_t o = (((size_t)l * 8 + wave) * 64 + 16 * nt + fr) * 64 + 32 * ks + 8 * fq;
                    Ba[nt][ks] = *(const pg8::bf16x8*)(Wa_t + o); Bx[nt][ks] = *(const pg8::bf16x8*)(Wx_t + o); }
            REP(4) for (int item = vcu; item < BH * NCH; item += G) {
                const int b = item % BH, c = item / BH;
                const size_t t0 = (size_t)b * SEQ + (size_t)c * CH;
                float xm3 = 0.f, xm2 = 0.f, xm1 = 0.f;
                if (c > 0) { xm3 = bf2f(proj[(t0 - 3) * PW + ch]); xm2 = bf2f(proj[(t0 - 2) * PW + ch]); xm1 = bf2f(proj[(t0 - 1) * PW + ch]); }
                float h = 0.f, P = 1.f;
                unsigned short xr[16];
#pragma unroll
                for (int j = 0; j < 16; ++j) xr[j] = proj[(t0 + j) * PW + ch];
#pragma unroll 1
                for (int g = 0; g < CH / 16; ++g) {
                    const size_t tg = t0 + 16 * g;
                    float xa[16];
#pragma unroll
                    for (int j = 0; j < 16; ++j) { const float xv = bf2f(xr[j]); xa[j] = cw0 * xm3 + cw1 * xm2 + cw2 * xm1 + cw3 * xv + cbias; xm3 = xm2; xm2 = xm1; xm1 = xv; }
                    { const size_t tn = (g + 1 < CH / 16) ? tg + 16 : tg;
#pragma unroll
                      for (int j = 0; j < 16; ++j) xr[j] = proj[(tn + j) * PW + ch]; }
#pragma unroll
                    for (int j = 0; j < 16; ++j) sA[j * 72 + lane] = (bf16)f2bf(xa[j]);
                    LDS_WAIT(); asm volatile("" ::: "memory");
                    const pg8::bf16x8 a0 = *(const LAS pg8::bf16x8*)(sA + fr * 72 + 8 * fq), a1 = *(const LAS pg8::bf16x8*)(sA + fr * 72 + 32 + 8 * fq);
                    f32x4 racc[4], iacc[4];
#pragma unroll
                    for (int nt = 0; nt < 4; ++nt) { racc[nt] = (f32x4){0.f, 0.f, 0.f, 0.f}; iacc[nt] = racc[nt];
                        racc[nt] = __builtin_amdgcn_mfma_f32_16x16x32_bf16(a0, Ba[nt][0], racc[nt], 0, 0, 0); racc[nt] = __builtin_amdgcn_mfma_f32_16x16x32_bf16(a1, Ba[nt][1], racc[nt], 0, 0, 0);
                        iacc[nt] = __builtin_amdgcn_mfma_f32_16x16x32_bf16(a0, Bx[nt][0], iacc[nt], 0, 0, 0); iacc[nt] = __builtin_amdgcn_mfma_f32_16x16x32_bf16(a1, Bx[nt][1], iacc[nt], 0, 0, 0); }
#pragma unroll
                    for (int nt = 0; nt < 4; ++nt)
#pragma unroll
                        for (int j = 0; j < 4; ++j) { sR[(4 * fq + j) * 68 + 16 * nt + fr] = racc[nt][j]; sI[(4 * fq + j) * 68 + 16 * nt + fr] = iacc[nt][j]; }
                    LDS_WAIT(); asm volatile("" ::: "memory");
                    {
                        typedef float f32x2v __attribute__((ext_vector_type(2)));
                        const float nk = -1.44269504089f;
                        bf16* hrow = hloc + tg * LW; bf16* prow = pcum + tg * LW;
#pragma unroll
                        for (int t = 0; t < 16; t += 2) {
                            const f32x2v sr = (f32x2v){sR[t * 68 + lane], sR[(t + 1) * 68 + lane]}, si = (f32x2v){sI[t * 68 + lane], sI[(t + 1) * 68 + lane]};
                            const f32x2v z1 = sr * nk + (nk * ba), z2 = si * nk + (nk * bx);
                            f32x2v e1, e2; e1.x = __builtin_amdgcn_exp2f(z1.x); e1.y = __builtin_amdgcn_exp2f(z1.y); e2.x = __builtin_amdgcn_exp2f(z2.x); e2.y = __builtin_amdgcn_exp2f(z2.y);
                            e1 = e1 + 1.0f; e2 = e2 + 1.0f;
                            f32x2v r, ig; r.x = __builtin_amdgcn_rcpf(e1.x); r.y = __builtin_amdgcn_rcpf(e1.y); ig.x = __builtin_amdgcn_rcpf(e2.x); ig.y = __builtin_amdgcn_rcpf(e2.y);
                            const f32x2v la = r * c2; f32x2v a; a.x = __builtin_amdgcn_exp2f(la.x); a.y = __builtin_amdgcn_exp2f(la.y);
                            const f32x2v m2 = 1.0f - a * a;
                            f32x2v mult; mult.x = __builtin_amdgcn_sqrtf(m2.x); mult.y = __builtin_amdgcn_sqrtf(m2.y);
                            const f32x2v bb = (mult * ig) * (f32x2v){xa[t], xa[t + 1]};
                            h = a.x * h + bb.x; P *= a.x;
                            { const unsigned w = pg8::cvt_pk_bf16(h, P); hrow[t * LW + ch] = (bf16)w; prow[t * LW + ch] = (bf16)(w >> 16); }
                            h = a.y * h + bb.y; P *= a.y;
                            { const unsigned w = pg8::cvt_pk_bf16(h, P); hrow[(t + 1) * LW + ch] = (bf16)w; prow[(t + 1) * LW + ch] = (bf16)(w >> 16); }
                        }
                    }
                    LDS_WAIT(); asm volatile("" ::: "memory");
                }
                Eh[((size_t)b * NCH + c) * LW + ch] = h; EP[((size_t)b * NCH + c) * LW + ch] = P;
            }
        }
        SEAM(ph); ++ph;
        if (RUN(ph)) {
            int lane; asm volatile("v_mbcnt_lo_u32_b32 %0, -1, 0\n\tv_mbcnt_hi_u32_b32 %0, -1, %0" : "=v"(lane));
            LAS float* sH = (LAS float*)lds;
            LAS float* sW = sH + 512;
            { const int ti = wave * 64 + lane; const float* wsrc = args.sc_conv_w + (size_t)l * 3 * LW + ti;
              const float t0_ = wsrc[0], t1_ = wsrc[LW], t2_ = wsrc[2 * LW]; sW[ti] = t0_; sW[ti + LW] = t1_; sW[ti + 2 * LW] = t2_; }
            __syncthreads();
            REP(8) for (int item = vcu; item < BH * NCH; item += G) {
                const int b = item % BH, c = item / BH;
                {
                    const int ch = 64 * wave + lane; const float* ep = EP + (size_t)b * NCH * LW + ch; const float* eh = Eh + (size_t)b * NCH * LW + ch;
                    float pj[NCH], hj[NCH];
#pragma unroll
                    for (int j = 0; j < NCH - 1; ++j) { pj[j] = 1.f; hj[j] = 0.f; if (j < c) { pj[j] = ep[j * LW]; hj[j] = eh[j * LW]; } }
                    float Hc = 0.f;
#pragma unroll
                    for (int j = 0; j < NCH - 1; ++j) Hc = pj[j] * Hc + hj[j];
                    sH[ch] = Hc;
                }
                __syncthreads();
                float H[8];
                { const f32x4 ha = *(const LAS f32x4*)(sH + 8 * lane), hb4 = *(const LAS f32x4*)(sH + 8 * lane + 4);
#pragma unroll
                  for (int e = 0; e < 4; ++e) { H[e] = ha[e]; H[4 + e] = hb4[e]; } }
                const int s0 = c * CH + (CH / NWAVES) * wave;
                const size_t t0 = (size_t)b * SEQ + s0;
                float cv1[8], cv2[8];
#pragma unroll
                for (int e = 0; e < 8; ++e) { cv1[e] = 0.f; cv2[e] = 0.f; }
                if (s0 > 0) { unpack8(*(const v4u*)(proj + (t0 - 1) * PW + 1536 + 8 * lane), cv1); unpack8(*(const v4u*)(proj + (t0 - 2) * PW + 1536 + 8 * lane), cv2); }
#pragma unroll 1
                for (int hf = 0; hf < CH / NWAVES / 4; ++hf) {
                    v4u raw[4][5];
#pragma unroll
                    for (int tt = 0; tt < 4; ++tt) { const size_t t = t0 + 4 * hf + tt;
                        raw[tt][0] = *(const v4u*)(hloc + t * LW + 8 * lane); raw[tt][1] = *(const v4u*)(pcum + t * LW + 8 * lane);
                        raw[tt][2] = *(const v4u*)(proj + t * PW + 512 + 8 * lane); raw[tt][3] = *(const v4u*)(proj + t * PW + 1024 + 8 * lane);
                        raw[tt][4] = *(const v4u*)(proj + t * PW + 1536 + 8 * lane); }
#pragma unroll
                    for (int tt = 0; tt < 4; ++tt) { const size_t t = t0 + 4 * hf + tt;
                        float hl[8], pc[8], gt[8], sb[8], cvn[8], ya[8], yv[8];
                        unpack8(raw[tt][0], hl); unpack8(raw[tt][1], pc); unpack8(raw[tt][2], gt); unpack8(raw[tt][3], sb); unpack8(raw[tt][4], cvn);
                        float sa = 0.f, sbq = 0.f, w0[8], w1[8], w2[8];
                        { const f32x4 a0 = *(const LAS f32x4*)(sW + 8 * lane), a1 = *(const LAS f32x4*)(sW + 8 * lane + 4), b0 = *(const LAS f32x4*)(sW + LW + 8 * lane), b1 = *(const LAS f32x4*)(sW + LW + 8 * lane + 4),
                                      c0 = *(const LAS f32x4*)(sW + 2 * LW + 8 * lane), c1 = *(const LAS f32x4*)(sW + 2 * LW + 8 * lane + 4);
#pragma unroll
                          for (int e = 0; e < 4; ++e) { w0[e] = a0[e]; w0[4 + e] = a1[e]; w1[e] = b0[e]; w1[4 + e] = b1[e]; w2[e] = c0[e]; w2[4 + e] = c1[e]; } }
#pragma unroll
                        for (int e = 0; e < 8; ++e) { const float hh = hl[e] + pc[e] * H[e]; ya[e] = hh * pg8::gelu_tanh(gt[e]); sa += ya[e] * ya[e];
                            const float cv = cvn[e]; yv[e] = sb[e] * (w0[e] * cv2[e] + w1[e] * cv1[e] + w2[e] * cv); sbq += yv[e] * yv[e]; cv2[e] = cv1[e]; cv1[e] = cv; }
                        sa = wave_sum(sa); sbq = wave_sum(sbq);
                        const float ra = __builtin_amdgcn_rsqf(sa * (1.0f / LW) + pg8::RMS_EPS), rb = __builtin_amdgcn_rsqf(sbq * (1.0f / LW) + pg8::RMS_EPS);
#pragma unroll
                        for (int e = 0; e < 8; ++e) { ya[e] *= ra; yv[e] *= rb; }
                        *(v4u*)(yb + t * D + 8 * lane) = pack8(ya); *(v4u*)(yb + t * D + LW + 8 * lane) = pack8(yv);
                        __builtin_amdgcn_sched_barrier(0);
                    }
                }
                __syncthreads();
            }
        }
        SEAM(ph); ++ph;
        if (RUN(ph)) {
            pg8::Gemm g{yb, Wout_t + (size_t)l * D * D, MH, D, D}; pg8::StaticOrder S; S.init(MH, D, G, chh, GX);
            pg8::EpiRes E{hb, ssq2};
            pg8::gemm_phase<pg8::EpiRes, pg8::StaticOrder, true, true>(lds, g, S, E);
        }
        SEAM(ph); ++ph;
        if (RUN(ph)) {
            pg8::Gemm g{hb, Wug_t + (size_t)l * 2 * FF * D, MH, 2 * FF, D}; pg8::StaticOrder S; S.init(MH, 2 * FF, G, chh, GX);
            pg8::EpiUG E{act, ssq2, args.mlp_conv_w + (size_t)l * 3 * FF, args.mlp_conv_b + (size_t)l * FF, fixb, (LAS float*)(lds + XCH_OFF)};
#if PROBE_DUP & 64
            { pg8::EpiProj E2{act, FF, ssq2, 1000, (LAS float*)(lds + XCH_OFF)}; pg8::gemm_phase<pg8::EpiProj, pg8::StaticOrder, true, true>(lds, g, S, E2); }
#endif
            REP(16) pg8::gemm_phase<pg8::EpiUG, pg8::StaticOrder, true, true>(lds, g, S, E);
            if (tid_k == 0) *(volatile LAS int*)(lds + XCH_OFF + 1536 * 4) = 0;
        }
        SEAM(ph); ++ph;
        if (RUN(ph)) {
            pg8::Gemm g{act, Wdn_t + (size_t)l * D * FF, MH, D, FF}; pg8::StaticOrder S; S.init(MH, D, G, chh, GX);
            {
                const float* cw = args.mlp_conv_w + (size_t)l * 3 * FF; const float* cb = args.mlp_conv_b + (size_t)l * FF;
                int tid = tid_k; asm volatile("" : "+v"(tid));
                pg8::Unit uu;
                for (int ui = 0; S.next(ui, uu); ++ui) {
                    const int pm = uu.pm;
                    for (int i = tid; i < FF / 4; i += NWAVES * 64) {
                        const int f = 4 * i;
                        const float* fb = fixb + (size_t)pm * 6 * FF + f;
                        const f32x4 u0 = *(const f32x4*)(fb), u1 = *(const f32x4*)(fb + FF), g0 = *(const f32x4*)(fb + 2 * FF), g1 = *(const f32x4*)(fb + 3 * FF);
                        f32x4 pm2 = (f32x4){0.f, 0.f, 0.f, 0.f}, pm1 = pm2;
                        if (pm % (SEQ / 256) != 0) { pm2 = *(const f32x4*)(fb - 2 * FF); pm1 = *(const f32x4*)(fb - FF); }
                        const f32x4 w0 = *(const f32x4*)(cw + f), w1 = *(const f32x4*)(cw + FF + f), w2 = *(const f32x4*)(cw + 2 * FF + f), bb = *(const f32x4*)(cb + f);
                        float o0[4], o1[4];
#pragma unroll
                        for (int e = 0; e < 4; ++e) { o0[e] = pg8::gelu_tanh(w0[e] * pm2[e] + w1[e] * pm1[e] + w2[e] * u0[e] + bb[e]) * g0[e];
                                                      o1[e] = pg8::gelu_tanh(w0[e] * pm1[e] + w1[e] * u0[e] + w2[e] * u1[e] + bb[e]) * g1[e]; }
                        typedef unsigned u32x2v __attribute__((ext_vector_type(2)));
                        u32x2v a; a.x = pg8::cvt_pk_bf16(o0[0], o0[1]); a.y = pg8::cvt_pk_bf16(o0[2], o0[3]); *(u32x2v*)(act + (size_t)(pm * 256) * FF + f) = a;
                        a.x = pg8::cvt_pk_bf16(o1[0], o1[1]); a.y = pg8::cvt_pk_bf16(o1[2], o1[3]); *(u32x2v*)(act + (size_t)(pm * 256 + 1) * FF + f) = a;
                    }
                }
                VM_WAIT(); __syncthreads();
            }
            pg8::EpiRes E{hb, ssq1};
            pg8::gemm_phase<pg8::EpiRes, pg8::StaticOrder, true, true>(lds, g, S, E);
        }
        SEAM(ph); ++ph;
    }
    if (RUN(ph)) {
        int lane; asm volatile("v_mbcnt_lo_u32_b32 %0, -1, 0\n\tv_mbcnt_hi_u32_b32 %0, -1, %0" : "=v"(lane));
        f32x4 gf[4];
#pragma unroll
        for (int j = 0; j < 4; ++j) gf[j] = *((const f32x4*)args.final_g + lane + 64 * j);
        for (int m = gw; m < MH; m += NGW) {
            const float pr = (lane < 16) ? ssq1[(size_t)m * 16 + lane] : 0.f;
            const float rs = __builtin_amdgcn_rsqf(wave_sum(pr) * (1.0f / D) + pg8::RMS_EPS);
            const GAS unsigned long long* hr = (const GAS unsigned long long*)(hb + (size_t)m * D) + lane;
            GAS f32x4* xr = (GAS f32x4*)(outp + (size_t)m * D) + lane;
#pragma unroll
            for (int j = 0; j < 4; ++j) { const unsigned long long q = hr[64 * j]; const unsigned qa = (unsigned)q, qb = (unsigned)(q >> 32);
                f32x4 v = (f32x4){bflo(qa), bfhi(qa), bflo(qb), bfhi(qb)}; v = v * rs * gf[j]; xr[64 * j] = v; }
        }
    }
#undef RUN
#undef SEAM
}
constexpr int N_PHASES = 2 + DEPTH * 6;
static_assert(MK_N_LAUNCHES == 1, "the two-half schedule is one cooperative launch");

extern "C" void kernel_launch(void* const* d_in, const int* in_sizes, int n_in, void* d_out, int out_size, void* d_ws, size_t ws_size, hipStream_t stream) {
    static int grid = 0;
    if (grid == 0) {
        if (n_in != 21 || in_sizes[0] != M * D || out_size != M * D || ws_size < WS_END) { fprintf(stderr, "kernel_launch: unexpected shapes (n_in %d, in0 %d, out %d, ws %zu); nothing launched\n", n_in, n_in > 0 ? in_sizes[0] : -1, out_size, ws_size); grid = -1; return; }
        int dev = 0, cus = 0, per_cu = 0;
        if (hipGetDevice(&dev) != hipSuccess || hipDeviceGetAttribute(&cus, hipDeviceAttributeMultiprocessorCount, dev) != hipSuccess) { grid = -1; return; }
        if (hipFuncSetAttribute((const void*)mk_fwd, hipFuncAttributeMaxDynamicSharedMemorySize, LDS_BYTES) != hipSuccess) { fprintf(stderr, "kernel_launch: hipFuncSetAttribute failed\n"); grid = -1; return; }
        if (hipOccupancyMaxActiveBlocksPerMultiprocessor(&per_cu, (const void*)mk_fwd, NWAVES * 64, LDS_BYTES) != hipSuccess || per_cu < 1) { fprintf(stderr, "kernel_launch: occupancy query says %d\n", per_cu); per_cu = 1; }
        (void)hipGetLastError();
        grid = cus;
        if (grid % 8 != 0 || grid < 64) { fprintf(stderr, "kernel_launch: the two-half schedule needs a multiple of 8 workgroups (got %d); nothing launched\n", grid); grid = -1; return; }
    }
    if (grid < 0) return;
    (void)hipMemsetAsync((char*)d_ws + WS_CTL, 0, CTL_ZERO_BYTES, stream);
    Args a{};
    const float** ap = (const float**)&a;
    for (int i = 0; i < 21; ++i) ap[i] = (const float*)d_in[i];
    a.out = (float*)d_out; a.ws = (unsigned char*)d_ws;
#if MK_N_LAUNCHES == 1
    a.ph_lo = 0; a.ph_hi = N_PHASES;
    void* kargs[] = {&a};
    hipError_t e = hipLaunchCooperativeKernel((const void*)mk_fwd, dim3(grid), dim3(NWAVES * 64), kargs, LDS_BYTES, stream);
    if (e != hipSuccess) fprintf(stderr, "kernel_launch: cooperative launch failed: %s (grid %d)\n", hipGetErrorString(e), grid);
#else
    for (int p = 0; p < N_PHASES; ++p) { a.ph_lo = p; a.ph_hi = p + 1; hipLaunchKernelGGL(mk_fwd, dim3(grid), dim3(NWAVES * 64), LDS_BYTES, stream, a); }
#endif
}
```
